# Optimizing an MI355X kernel written in HIP

```python
import math
import jax, jax.numpy as jnp
from jax import lax
import numpy as np

D_MODEL = 1024
BATCH = 32
SEQ = 2048
DEPTH = 1

META_TOKENS = 16
MIX_WIDTH = D_MODEL
CONV_WIDTH = MIX_WIDTH // 2
CONV_K = 3
GDN_HEADS = 4
GDN_HEAD_DIM = 128
GDN_WIDTH = GDN_HEADS * GDN_HEAD_DIM
GDN_CONV_K = 4
CHUNK = 64
IN_COLS = 3 * CONV_WIDTH + 4 * GDN_WIDTH + 2 * GDN_HEADS
N_EXPERTS = 256
TOP_K = 8
N_GROUPS = 8
TOPK_GROUPS = 4
E_PER_GROUP = N_EXPERTS // N_GROUPS
EXPERT_FF = 256
SHARED_FF = 256
ROUTED_SCALE = 2.5
MOE_BLOCK = 256
DN_ALPHA = (2 * DEPTH) ** 0.25
DN_BETA = (8 * DEPTH) ** -0.25
NORM_EPS = 1e-5

kernel_name = 'hymba_conv_gdn_moe_deepnorm'


def layer_norm(x, g, b):
    xf = x.astype(jnp.float32)
    mu = jnp.mean(xf, -1, keepdims=True)
    var = jnp.mean(jnp.square(xf - mu), -1, keepdims=True)
    y = (xf - mu) * lax.rsqrt(var + NORM_EPS) * g.astype(jnp.float32) + b.astype(jnp.float32)
    return y.astype(x.dtype)


def rms_norm(x, g):
    xf = x.astype(jnp.float32)
    y = xf * lax.rsqrt(jnp.mean(jnp.square(xf), -1, keepdims=True) + NORM_EPS) * g.astype(jnp.float32)
    return y.astype(x.dtype)


def l2_normalize(x):
    xf = x.astype(jnp.float32)
    return xf * lax.rsqrt(jnp.sum(jnp.square(xf), -1, keepdims=True) + 1e-6)


def causal_depthwise_conv(u, w):
    K = w.shape[0]
    L = u.shape[1]
    up = jnp.pad(u, ((0, 0), (K - 1, 0), (0, 0)))
    y = up[:, 0:L] * w[0]
    for j in range(1, K):
        y = y + up[:, j:j + L] * w[j]
    return y


def chunked_gated_delta_rule(q, k, v, g, beta):
    bsz, L, H, dk = q.shape
    dv = v.shape[-1]
    pad = (-L) % CHUNK
    n = (L + pad) // CHUNK

    def chunks(t):
        t = jnp.pad(t.astype(jnp.float32), ((0, 0), (pad, 0)) + ((0, 0),) * (t.ndim - 2))
        t = t.reshape((bsz, n, CHUNK) + t.shape[2:])
        return jnp.moveaxis(t, (1, 3), (0, 2))

    q, k, v, g, beta = chunks(q), chunks(k), chunks(v), chunks(g), chunks(beta)
    gc = jnp.cumsum(g, axis=-1)
    causal = jnp.tril(jnp.ones((CHUNK, CHUNK), dtype=bool))
    decay = jnp.exp(jnp.where(causal, gc[..., :, None] - gc[..., None, :], -jnp.inf))
    k_beta = k * beta[..., None]
    lower = jnp.tril(jnp.einsum('nbhid,nbhjd->nbhij', k_beta, k) * decay, -1)
    a_mat = jnp.eye(CHUNK, dtype=jnp.float32) + lower
    rhs = jnp.concatenate([v * beta[..., None], k_beta * jnp.exp(gc)[..., None]], axis=-1)
    sol = lax.linalg.triangular_solve(a_mat, rhs, left_side=True, lower=True, unit_diagonal=True)
    u, w = sol[..., :dv], sol[..., dv:]
    attn = jnp.einsum('nbhid,nbhjd->nbhij', q, k) * decay
    q_dec = q * jnp.exp(gc)[..., None]
    g_last = gc[..., -1]
    k_dec = k * jnp.exp(g_last[..., None] - gc)[..., None]

    def step(S, xs):
        q_n, k_n, u_n, w_n, a_n, gl_n = xs
        v_new = u_n - jnp.einsum('bhck,bhkv->bhcv', w_n, S)
        o_n = jnp.einsum('bhck,bhkv->bhcv', q_n, S) + jnp.einsum('bhij,bhjv->bhiv', a_n, v_new)
        S = S * jnp.exp(gl_n)[..., None, None] + jnp.einsum('bhck,bhcv->bhkv', k_n, v_new)
        return S, o_n

    S0 = jnp.zeros((bsz, H, dk, dv), jnp.float32)
    _, o = lax.scan(step, S0, (q_dec, k_dec, u, w, attn, g_last))
    o = jnp.moveaxis(o, (0, 2), (1, 3)).reshape(bsz, n * CHUNK, H, dv)
    return o[:, pad:]


def hybrid_mixer(h, w_in, conv_w, conv_norm_w, gdn_conv_w, a_log, dt_bias, gdn_norm_w, w_out):
    bsz, L, _ = h.shape
    c, gw = CONV_WIDTH, GDN_WIDTH
    cuts = [c, 2 * c, 3 * c, 3 * c + 3 * gw, 3 * c + 4 * gw, 3 * c + 4 * gw + GDN_HEADS]
    gate_b, gate_c, conv_in, qkv, z, beta_in, decay_in = jnp.split(h @ w_in, cuts, axis=-1)
    y_conv = gate_b * causal_depthwise_conv(gate_c * conv_in, conv_w)
    y_conv = rms_norm(y_conv, conv_norm_w)
    qkv = jax.nn.silu(causal_depthwise_conv(qkv, gdn_conv_w))
    qkv = qkv.reshape(bsz, L, 3, GDN_HEADS, GDN_HEAD_DIM)
    q = l2_normalize(qkv[:, :, 0]) * (GDN_HEAD_DIM ** -0.5)
    k = l2_normalize(qkv[:, :, 1])
    v = qkv[:, :, 2]
    beta = jax.nn.sigmoid(beta_in.astype(jnp.float32))
    g = -jnp.exp(a_log.astype(jnp.float32)) * jax.nn.softplus(decay_in.astype(jnp.float32) + dt_bias.astype(jnp.float32))
    o = chunked_gated_delta_rule(q, k, v, g, beta)
    o = rms_norm(o, gdn_norm_w) * jax.nn.silu(z.reshape(bsz, L, GDN_HEADS, GDN_HEAD_DIM).astype(jnp.float32))
    y_gdn = o.reshape(bsz, L, GDN_WIDTH).astype(h.dtype)
    return jnp.concatenate([y_conv, y_gdn], axis=-1) @ w_out


def moe_ffn(h, w_router, b_router, w_gate, w_up, w_down, ws_gate, ws_up, ws_down):
    bsz, L, D = h.shape
    x2d = h.reshape(-1, D)
    T = x2d.shape[0]
    scores = jax.nn.sigmoid((x2d @ w_router).astype(jnp.float32))
    sel = scores + b_router.astype(jnp.float32)
    grp_score = jnp.sum(lax.top_k(sel.reshape(T, N_GROUPS, E_PER_GROUP), 2)[0], axis=-1)
    _, top_g = lax.top_k(grp_score, TOPK_GROUPS)
    gmask = jnp.sum(jax.nn.one_hot(top_g, N_GROUPS, dtype=jnp.float32), axis=1) > 0
    sel = jnp.where(jnp.repeat(gmask, E_PER_GROUP, axis=1), sel, -jnp.inf)
    _, idx = lax.top_k(sel, TOP_K)
    gate = jnp.take_along_axis(scores, idx, axis=1)
    gate = gate / jnp.sum(gate, -1, keepdims=True) * ROUTED_SCALE
    TK = T * TOP_K
    flat_e = idx.reshape(TK)
    flat_t = jnp.repeat(jnp.arange(T, dtype=jnp.int32), TOP_K)
    flat_g = gate.reshape(TK)
    order = jnp.argsort(flat_e)
    e_sorted = flat_e[order]
    counts = jnp.bincount(flat_e, length=N_EXPERTS)
    pcounts = (counts + MOE_BLOCK - 1) // MOE_BLOCK * MOE_BLOCK
    pends = jnp.cumsum(pcounts)
    pstarts = pends - pcounts
    starts = jnp.cumsum(counts) - counts
    dest = pstarts[e_sorted] + jnp.arange(TK, dtype=jnp.int32) - starts[e_sorted]
    n_blocks = -(-TK // MOE_BLOCK) + N_EXPERTS
    slot_tok = jnp.zeros((n_blocks * MOE_BLOCK,), jnp.int32).at[dest].set(flat_t[order])
    slot_gate = jnp.zeros((n_blocks * MOE_BLOCK,), jnp.float32).at[dest].set(flat_g[order])
    block_e = jnp.minimum(jnp.searchsorted(pends, jnp.arange(n_blocks, dtype=jnp.int32) * MOE_BLOCK, side='right'), N_EXPERTS - 1)

    def body(out, blk):
        tok, gw, e = blk
        xb = x2d[tok]
        hb = jax.nn.silu(xb @ w_gate[e]) * (xb @ w_up[e])
        yb = (hb @ w_down[e]) * gw[:, None].astype(x2d.dtype)
        return out.at[tok].add(yb), None

    routed, _ = lax.scan(body, jnp.zeros_like(x2d),
                         (slot_tok.reshape(n_blocks, MOE_BLOCK), slot_gate.reshape(n_blocks, MOE_BLOCK), block_e))
    shared = (jax.nn.silu(x2d @ ws_gate) * (x2d @ ws_up)) @ ws_down
    return (routed + shared).reshape(bsz, L, D)


def setup_inputs(seed: int = 0) -> dict:
    key = jax.random.key(seed)
    ks = jax.random.split(key, 24)

    def nrm(k, shape, scale):
        return jax.random.normal(k, shape, jnp.float32) * scale

    x = nrm(ks[0], (BATCH, SEQ, D_MODEL), 1.0)
    meta_tokens = nrm(ks[1], (META_TOKENS, D_MODEL), 1.0)
    col_scale = jnp.concatenate([
        jnp.ones((2 * CONV_WIDTH,), jnp.float32), jnp.full((CONV_WIDTH,), DN_BETA, jnp.float32),
        jnp.ones((2 * GDN_WIDTH,), jnp.float32), jnp.full((GDN_WIDTH,), DN_BETA, jnp.float32),
        jnp.ones((GDN_WIDTH + 2 * GDN_HEADS,), jnp.float32)])
    w_in = nrm(ks[2], (DEPTH, D_MODEL, IN_COLS), D_MODEL ** -0.5) * col_scale
    conv_w = nrm(ks[3], (DEPTH, CONV_K, CONV_WIDTH), CONV_K ** -0.5)
    conv_norm_w = 1.0 + nrm(ks[4], (DEPTH, CONV_WIDTH), 0.01)
    gdn_conv_w = nrm(ks[5], (DEPTH, GDN_CONV_K, 3 * GDN_WIDTH), GDN_CONV_K ** -0.5)
    a_log = jnp.log(jax.random.uniform(ks[6], (DEPTH, GDN_HEADS), jnp.float32, 1.0, 16.0))
    dt = jnp.exp(jax.random.uniform(ks[7], (DEPTH, GDN_HEADS), jnp.float32, math.log(1e-3), math.log(1e-1)))
    dt_bias = dt + jnp.log(-jnp.expm1(-dt))
    gdn_norm_w = 1.0 + nrm(ks[8], (DEPTH, GDN_HEAD_DIM), 0.01)
    w_out = nrm(ks[9], (DEPTH, MIX_WIDTH, D_MODEL), MIX_WIDTH ** -0.5 * DN_BETA)
    ln1_g = 1.0 + nrm(ks[10], (DEPTH, D_MODEL), 0.01)
    ln1_b = nrm(ks[11], (DEPTH, D_MODEL), 0.01)
    w_router = nrm(ks[12], (DEPTH, D_MODEL, N_EXPERTS), D_MODEL ** -0.5)
    b_router = nrm(ks[13], (DEPTH, N_EXPERTS), 0.01)
    w_gate = nrm(ks[14], (DEPTH, N_EXPERTS, D_MODEL, EXPERT_FF), D_MODEL ** -0.5)
    w_up = nrm(ks[15], (DEPTH, N_EXPERTS, D_MODEL, EXPERT_FF), D_MODEL ** -0.5)
    w_down = nrm(ks[16], (DEPTH, N_EXPERTS, EXPERT_FF, D_MODEL), EXPERT_FF ** -0.5 * DN_BETA)
    ws_gate = nrm(ks[17], (DEPTH, D_MODEL, SHARED_FF), D_MODEL ** -0.5)
    ws_up = nrm(ks[18], (DEPTH, D_MODEL, SHARED_FF), D_MODEL ** -0.5)
    ws_down = nrm(ks[19], (DEPTH, SHARED_FF, D_MODEL), SHARED_FF ** -0.5 * DN_BETA)
    ln2_g = 1.0 + nrm(ks[20], (DEPTH, D_MODEL), 0.01)
    ln2_b = nrm(ks[21], (DEPTH, D_MODEL), 0.01)
    return {'x': x, 'meta_tokens': meta_tokens, 'w_in': w_in, 'conv_w': conv_w, 'conv_norm_w': conv_norm_w,
            'gdn_conv_w': gdn_conv_w, 'a_log': a_log, 'dt_bias': dt_bias, 'gdn_norm_w': gdn_norm_w,
            'w_out': w_out, 'ln1_g': ln1_g, 'ln1_b': ln1_b, 'w_router': w_router, 'b_router': b_router,
            'w_gate': w_gate, 'w_up': w_up, 'w_down': w_down, 'ws_gate': ws_gate, 'ws_up': ws_up,
            'ws_down': ws_down, 'ln2_g': ln2_g, 'ln2_b': ln2_b}


def reference(x, meta_tokens, w_in, conv_w, conv_norm_w, gdn_conv_w, a_log, dt_bias, gdn_norm_w,
              w_out, ln1_g, ln1_b, w_router, b_router, w_gate, w_up, w_down, ws_gate, ws_up,
              ws_down, ln2_g, ln2_b):
    bsz = x.shape[0]
    meta = jnp.broadcast_to(meta_tokens[None].astype(x.dtype), (bsz, META_TOKENS, x.shape[-1]))
    h = jnp.concatenate([meta, x], axis=1)
    for l in range(DEPTH):
        mix = hybrid_mixer(h, w_in[l], conv_w[l], conv_norm_w[l], gdn_conv_w[l], a_log[l], dt_bias[l],
                           gdn_norm_w[l], w_out[l])
        h = layer_norm(DN_ALPHA * h + mix, ln1_g[l], ln1_b[l])
        ffn = moe_ffn(h, w_router[l], b_router[l], w_gate[l], w_up[l], w_down[l], ws_gate[l], ws_up[l], ws_down[l])
        h = layer_norm(DN_ALPHA * h + ffn, ln2_g[l], ln2_b[l])
    return h[:, META_TOKENS:]
```

```cpp
#include <hip/hip_runtime.h>
#include <cstdio>
#include <cstdint>

#ifndef DBG_STAGE
#define DBG_STAGE 0
#endif
#ifndef MK_LAUNCHES
#define MK_LAUNCHES 1
#endif

#define LAS __attribute__((address_space(3)))
#define GAS __attribute__((address_space(1)))
typedef unsigned short bf16;
typedef short bf16x8 __attribute__((ext_vector_type(8)));
typedef float f32x4 __attribute__((ext_vector_type(4)));
typedef float f32x2 __attribute__((ext_vector_type(2)));
typedef unsigned u32x4 __attribute__((ext_vector_type(4)));
typedef unsigned u32x2 __attribute__((ext_vector_type(2)));

constexpr int BATCH = 32, SEQ = 2048, D = 1024, T = BATCH * SEQ;
constexpr int NMETA = 16, CW = 512, GWID = 512, NHEAD = 4, HD = 128, INC = 3592, NPJ = 3584;
constexpr int NE = 256, TOPK = 8, EFF = 256;
constexpr float ALPHA = 1.189207115002721f, EPS = 1e-5f;
constexpr int NPHASE = 15;
constexpr int NTHREADS = 512, NWAVES = 8;
constexpr int NSR = T * TOPK;
constexpr int NSLOT = NSR + T;
constexpr int HALF_T = T / 2;

constexpr size_t MiB = 1u << 20;
constexpr size_t WS_CTL = 0, CTL_BYTES = 1 * MiB;
constexpr size_t WS_TAB = 1 * MiB;
constexpr size_t TB_WGCNT = WS_TAB;
constexpr size_t TB_GTAB = TB_WGCNT + 256 * 256 * 4;
constexpr size_t TB_EIDX = TB_GTAB + 16 * 260 * 4 + 1536;
constexpr size_t TB_EGATE = TB_EIDX + (size_t)T * 8 * 4;
constexpr size_t TB_YROW = TB_EGATE + (size_t)T * 8 * 4;
constexpr size_t TB_STOK = TB_YROW + (size_t)T * 8 * 4;
constexpr size_t TB_SGATE = TB_STOK + (size_t)(NSLOT + 256) * 4;
constexpr size_t TB_BD = TB_SGATE + (size_t)(NSLOT + 256) * 4;
constexpr size_t TB_BETA = TB_BD + (size_t)T * 8 * 4;
constexpr size_t TB_G = TB_BETA + (size_t)T * 4 * 4;
constexpr size_t TB_PROJM = TB_G + (size_t)T * 4 * 4;
constexpr size_t TB_METAQ = TB_PROJM + 16 * INC * 4;
constexpr size_t TB_METAK = TB_METAQ + 64 * 512 * 2;
constexpr size_t TB_METAV = TB_METAK + 64 * 512 * 2;
constexpr size_t TB_METAB = TB_METAV + 64 * 512 * 2;
constexpr size_t TB_METAG = TB_METAB + 64 * 4 * 4;
constexpr size_t TB_END = TB_METAG + 64 * 4 * 4;
constexpr size_t WS_WSM = 17 * MiB;
constexpr size_t W_WINT = WS_WSM;
constexpr size_t W_WOUTT = W_WINT + (size_t)NPJ * D * 2;
constexpr size_t W_WRT = W_WOUTT + (size_t)D * D * 2;
constexpr size_t W_WSGU = W_WRT + (size_t)NE * D * 2;
constexpr size_t W_WSD = W_WSGU + (size_t)512 * D * 2;
constexpr size_t W_END = W_WSD + (size_t)D * EFF * 2;
constexpr size_t WS_RA = 29 * MiB;
constexpr size_t WS_RB = 157 * MiB;
constexpr size_t WS_HBUF = 157 * MiB;
constexpr size_t WS_X = 446 * MiB;
constexpr size_t WS_QN = 605 * MiB, WS_KN = 669 * MiB, WS_VV = 733 * MiB;
constexpr size_t WS_ZB = 797 * MiB;
constexpr size_t WS_MIX = 733 * MiB;
constexpr size_t WS_LOGITS = 861 * MiB;
constexpr size_t WS_END = 958 * MiB;
constexpr int GBLK = 81920;
constexpr int GB_UT = 0, GB_WP = 18432, GB_QD = 35840, GB_KDT = 53248, GB_ATT = 71680, GB_EG = 80896;
static_assert(TB_END <= WS_WSM && W_END <= WS_RA, "ws map");
static_assert(WS_RB + (size_t)T * NPJ * 2 <= WS_QN && WS_RB + (size_t)4100 * GBLK <= WS_QN, "ws map");
static_assert(WS_HBUF + (size_t)(NSLOT + 256) * 512 <= WS_X && WS_X + (size_t)(NE * 512) * D * 2 <= WS_MIX, "ws map");
static_assert(WS_X + (size_t)(HALF_T * 8) * 2048 <= WS_END, "ws map");

constexpr int CW_BAR = 4096;

constexpr int LDS_STAGE = 0;
constexpr int LDS_AUX = 131072;
constexpr int LDS_TS = LDS_AUX + 20480;
constexpr int LDS_MISC = LDS_TS + 9344;
constexpr int LDS_BYTES = LDS_MISC + 128;
static_assert(LDS_BYTES <= 163840, "LDS");

__device__ __forceinline__ unsigned cvt_pk_bf16(float lo, float hi) { unsigned r; asm("v_cvt_pk_bf16_f32 %0, %1, %2" : "=v"(r) : "v"(lo), "v"(hi)); return r; }
__device__ __forceinline__ float bf_lo(unsigned w) { return __uint_as_float(w << 16); }
__device__ __forceinline__ float bf_hi(unsigned w) { return __uint_as_float(w & 0xffff0000u); }
__device__ __forceinline__ float bf2f(bf16 b) { return __uint_as_float(((unsigned)b) << 16); }
__device__ __forceinline__ void unpack8(const u32x4 w, float (&o)[8]) { o[0] = bf_lo(w.x); o[1] = bf_hi(w.x); o[2] = bf_lo(w.y); o[3] = bf_hi(w.y); o[4] = bf_lo(w.z); o[5] = bf_hi(w.z); o[6] = bf_lo(w.w); o[7] = bf_hi(w.w); }
__device__ __forceinline__ u32x4 pack8(const float (&v)[8]) { u32x4 w; w.x = cvt_pk_bf16(v[0], v[1]); w.y = cvt_pk_bf16(v[2], v[3]); w.z = cvt_pk_bf16(v[4], v[5]); w.w = cvt_pk_bf16(v[6], v[7]); return w; }
__device__ __forceinline__ float wave_sum(float v) {
#pragma unroll
    for (int o = 1; o < 64; o <<= 1) v += __shfl_xor(v, o);
    return v;
}
__device__ __forceinline__ float fast_exp(float x) { return __builtin_amdgcn_exp2f(x * 1.4426950408889634f); }
__device__ __forceinline__ float sigmoidf_(float x) { return __builtin_amdgcn_rcpf(1.0f + fast_exp(-x)); }
__device__ __forceinline__ float siluf_(float x) { return x * sigmoidf_(x); }
#define LDS_WAIT() asm volatile("s_waitcnt lgkmcnt(0)" ::: "memory")
#define VM_WAIT() asm volatile("s_waitcnt vmcnt(0)" ::: "memory")

#define XB_TMO      128
#define XB_XCNT(j)  (256  + 64 * (j))
#define XB_XSUB(j)  (1280 + 64 * (j))
#define XB_XGEN(j)  (2304 + 64 * (j))
#define XB_TOP      3328
#define XB_TOPGEN   3392
#define XCD_BAR_WORDS 3456
#define XB_SPIN_CAP (1u << 22)
__device__ __forceinline__ unsigned xb_ld(unsigned* p)              { return __hip_atomic_load(p, __ATOMIC_RELAXED, __HIP_MEMORY_SCOPE_AGENT); }
__device__ __forceinline__ unsigned xb_add(unsigned* p, unsigned v) { return __hip_atomic_fetch_add(p, v, __ATOMIC_RELAXED, __HIP_MEMORY_SCOPE_AGENT); }
__device__ __forceinline__ unsigned xb_xcc_id() { return (unsigned)__builtin_amdgcn_s_getreg((3 << 11) | 20) & 0xFu; }
#define XB_SPIN(cond, bar) do { unsigned _sp = 0; while (cond) { __builtin_amdgcn_s_sleep(1); \
    if ((++_sp & 255u) == 0u) { if (xb_ld(&(bar)[XB_TMO])) break; if (_sp > XB_SPIN_CAP) { atomicAdd(&(bar)[XB_TMO], 1u); break; } } } } while (0)
struct XcdBarrier { unsigned* bar; unsigned x; volatile LAS unsigned* st; };
__device__ __forceinline__ XcdBarrier xcd_barrier_post(unsigned* bar, volatile LAS unsigned* st) {
    XcdBarrier b; b.bar = bar; b.x = xb_xcc_id(); b.st = st;
    if (threadIdx.x == 0) (void)xb_add(&bar[XB_XCNT(b.x)], 1u);
    return b;
}
__device__ __forceinline__ void xcd_barrier_complete(unsigned* bar, unsigned x, unsigned& nloc, unsigned& nx) {
    const unsigned G = gridDim.x * gridDim.y * gridDim.z;
    unsigned sum, cnt, mine, sp = 0u;
    for (;;) {
        sum = 0u; cnt = 0u; mine = 0u;
#pragma unroll
        for (unsigned j = 0; j < 16; ++j) { const unsigned c = xb_ld(&bar[XB_XCNT(j)]); sum += c; cnt += (c > 0u) ? 1u : 0u; mine = (j == x) ? c : mine; }
        if (sum == G) break;
        __builtin_amdgcn_s_sleep(1);
        if ((++sp & 255u) == 0u) { if (xb_ld(&bar[XB_TMO])) break; if (sp > XB_SPIN_CAP) { atomicAdd(&bar[XB_TMO], 1u); break; } }
    }
    nloc = mine > 0u ? mine : 1u; nx = cnt > 0u ? cnt : 1u;
}
__device__ __forceinline__ void xcd_barrier(const XcdBarrier& b) {
    asm volatile("s_waitcnt vmcnt(0)" ::: "memory");
    __syncthreads();
    if (threadIdx.x == 0) {
        unsigned* bar = b.bar;
        __builtin_amdgcn_s_waitcnt(0);
        unsigned nloc = b.st[0], nx = b.st[1];
        if (nloc == 0u) { xcd_barrier_complete(bar, b.x, nloc, nx); b.st[0] = nloc; b.st[1] = nx; }
        const unsigned old = xb_add(&bar[XB_XSUB(b.x)], 1u);
        const unsigned gen = old / nloc;
        if (old + 1u == (gen + 1u) * nloc) {
            __builtin_amdgcn_fence(__ATOMIC_RELEASE, "agent");
            asm volatile("s_waitcnt vmcnt(0)" ::: "memory");
            const unsigned og = xb_add(&bar[XB_TOP], 1u);
            const unsigned tg = og / nx;
            if (og + 1u == (tg + 1u) * nx) xb_add(&bar[XB_TOPGEN], 1u);
            else XB_SPIN(xb_ld(&bar[XB_TOPGEN]) == tg, bar);
            __builtin_amdgcn_fence(__ATOMIC_ACQUIRE, "agent");
            xb_add(&bar[XB_XGEN(b.x)], 1u);
            asm volatile("s_waitcnt vmcnt(0)" ::: "memory");
        } else {
            XB_SPIN(xb_ld(&bar[XB_XGEN(b.x)]) == gen, bar);
            __builtin_amdgcn_fence(__ATOMIC_ACQUIRE, "agent");
            asm volatile("s_waitcnt vmcnt(0)" ::: "memory");
        }
    }
    __syncthreads();
}

namespace g8 {
constexpr int BM = 256, BK = 64, HALF = 128, HTB = HALF * BK * 2, STAGE_BYTES = 8 * HTB, NXCD = 8, WGM = 8;
__host__ __device__ __forceinline__ int lds_byte(int r, int c) { const int st = (r >> 4) * 2 + (c >> 5), rr = r & 15, cc = c & 31, ob = rr * 64 + cc * 2; return st * 1024 + (ob ^ (((ob >> 9) & 1) << 5)); }
__host__ __device__ __forceinline__ void stage_rc(int b, int& R, int& C) { const int st = b / 1024, sb = b % 1024, swz = sb ^ (((sb >> 9) & 1) << 5); R = (st >> 1) * 16 + swz / 64; C = (st & 1) * 32 + (swz % 64) / 2; }
__host__ __device__ __forceinline__ int perm32(int rho) { const int n = rho >> 4, i = rho & 15; return 8 * (i >> 2) + 4 * n + (i & 3); }

struct UnitG { const char* A; const char* B; char* O; int ldo; int p0, p1, p2; };

template <class Epi, class Sched>
__device__ __forceinline__ void gemm_core(LAS unsigned char* lds, const int K, const Sched& S, const Epi& E) {
    int tid = threadIdx.x; asm volatile("" : "+v"(tid));
    const int wid = __builtin_amdgcn_readfirstlane(tid >> 6), lane = tid & 63, wr = wid >> 2, wc = wid & 3, fr = lane & 15, fq = lane >> 4;
    const int nt = K / BK;
    int R0, C0; stage_rc(tid * 16, R0, C0);
    unsigned voffB[2];
#pragma unroll
    for (int i = 0; i < 2; ++i) { const int R = R0 + 64 * i; const int Rb = Epi::PERM ? ((R & ~31) + perm32(R & 31)) : R; voffB[i] = (unsigned)(Rb * K + C0) * 2u; }
    const size_t kstep = (size_t)(BK * 2);
    const size_t hstep = (size_t)HALF * K * 2;
    const unsigned ldsw = (unsigned)wid * 1024u;
    const int aoff = lds_byte(wr * 64 + fr, fq * 8), boff = lds_byte(wc * 32 + fr, fq * 8);
#define G8_SA(b, h) (((b) * 2 + (h)) * HTB)
#define G8_SB(b, h) ((4 + (b) * 2 + (h)) * HTB)
#define G8_STAGE(bufoff, gbase, voff) do { _Pragma("unroll") for (int _i = 0; _i < 2; ++_i) \
        __builtin_amdgcn_global_load_lds((const unsigned*)((const char*)(gbase) + (voff)[_i]), (LAS unsigned*)(lds + (bufoff) + ldsw + _i * 8192), 16, 0, 0); } while (0)
#define G8_STAGE_A(bufoff, gbase, h) do { if constexpr (Sched::GATHER) { G8_STAGE(bufoff, gbase, ao[h]); } else { G8_STAGE(bufoff, (gbase) + (h) * hstepA, ao[0]); } } while (0)
#define G8_LDA(dst, b, h) do { _Pragma("unroll") for (int m = 0; m < 4; ++m) _Pragma("unroll") for (int k = 0; k < 2; ++k) dst[m][k] = *(const LAS bf16x8*)(lds + G8_SA(b, h) + aoff + m * 2048 + k * 1024); } while (0)
#define G8_LDB(dst, b, h) do { _Pragma("unroll") for (int n = 0; n < 2; ++n) _Pragma("unroll") for (int k = 0; k < 2; ++k) dst[n][k] = *(const LAS bf16x8*)(lds + G8_SB(b, h) + boff + n * 2048 + k * 1024); } while (0)
#define G8_MMA(ai, bj, At, Bt) do { __builtin_amdgcn_s_setprio(1); _Pragma("unroll") for (int m = 0; m < 4; ++m) _Pragma("unroll") for (int n = 0; n < 2; ++n) _Pragma("unroll") for (int k = 0; k < 2; ++k) \
        acc[ai][bj][m][n] = __builtin_amdgcn_mfma_f32_16x16x32_bf16(Bt[n][k], At[m][k], acc[ai][bj][m][n], 0, 0, 0); __builtin_amdgcn_s_setprio(0); } while (0)
#define G8_WAIT_V(n) asm volatile("s_waitcnt vmcnt(" #n ")" ::: "memory")
#define G8_WAIT_L(n) asm volatile("s_waitcnt lgkmcnt(" #n ")" ::: "memory")
#define G8_BAR __builtin_amdgcn_s_barrier()
#define G8_SCHED __builtin_amdgcn_sched_barrier(0)
    UnitG cur, nxt; int ui = 0;
    if (!S.next(0, cur)) return;
    f32x4 acc[2][2][4][2];
#pragma unroll
    for (int a = 0; a < 2; ++a)
#pragma unroll
        for (int b = 0; b < 2; ++b)
#pragma unroll
            for (int m = 0; m < 4; ++m)
#pragma unroll
                for (int n = 0; n < 2; ++n) acc[a][b][m][n] = (f32x4){0.f, 0.f, 0.f, 0.f};
    bf16x8 At[4][2], B0[2][2], B1[2][2];
    unsigned ao[2][2];
    const size_t hstepA = (size_t)HALF * S.pitch();
#pragma unroll
    for (int i = 0; i < 2; ++i) { ao[0][i] = S.aoff(0, R0 + 64 * i, C0 * 2); ao[1][i] = Sched::GATHER ? S.aoff(0, R0 + 64 * i + 128, C0 * 2) : 0u; }
    const char* cA = cur.A; const char* cB = cur.B;
    G8_STAGE(G8_SB(0, 0), cB, voffB); G8_STAGE(G8_SB(0, 1), cB + hstep, voffB); G8_STAGE_A(G8_SA(0, 0), cA, 0); G8_STAGE_A(G8_SA(0, 1), cA, 1);
    if (wr == 1) G8_BAR;
    G8_WAIT_V(2); G8_BAR;
    G8_STAGE(G8_SB(1, 0), cB + kstep, voffB); G8_STAGE_A(G8_SA(1, 0), cA + kstep, 0); G8_STAGE(G8_SB(1, 1), cB + hstep + kstep, voffB);
    G8_WAIT_V(6); G8_BAR;
    for (;;) {
        const bool has_next = S.next(ui + 1, nxt);
        const char* nA = has_next ? nxt.A : cA; const char* nB = has_next ? nxt.B : cB;
#pragma unroll 1
        for (int t = 0; t < nt; t += 2) {
            const bool last = (t == nt - 2);
            const char* a1 = cA + (size_t)(t + 1) * kstep;
            const char* a2 = last ? nA : cA + (size_t)(t + 2) * kstep; const char* b2 = last ? nB : cB + (size_t)(t + 2) * kstep;
            const char* a3 = a2 + kstep; const char* b3 = b2 + kstep;
            if constexpr (Sched::GATHER) { if (last && has_next) {
#pragma unroll
                for (int i = 0; i < 2; ++i) ao[0][i] = S.aoff(ui + 1, R0 + 64 * i, C0 * 2); } }
            G8_LDB(B0, 0, 0); G8_LDB(B1, 0, 1); G8_SCHED; G8_LDA(At, 0, 0); G8_STAGE_A(G8_SA(1, 1), a1, 1);
            if constexpr (Sched::GATHER) { if (last && has_next) {
#pragma unroll
                for (int i = 0; i < 2; ++i) ao[1][i] = S.aoff(ui + 1, R0 + 64 * i + 128, C0 * 2); } }
            G8_WAIT_V(8); G8_WAIT_L(0); G8_BAR; G8_MMA(0, 0, At, B0); G8_MMA(0, 1, At, B1); G8_BAR; G8_SCHED;
            G8_LDA(At, 0, 1); G8_STAGE(G8_SB(0, 0), b2, voffB); G8_STAGE(G8_SB(0, 1), b2 + hstep, voffB); G8_STAGE_A(G8_SA(0, 0), a2, 0);
            G8_WAIT_V(8); G8_WAIT_L(0); G8_BAR; G8_MMA(1, 0, At, B0); G8_MMA(1, 1, At, B1); G8_BAR; G8_SCHED;
            G8_LDB(B0, 1, 0); G8_LDB(B1, 1, 1); G8_SCHED; G8_LDA(At, 1, 0); G8_STAGE_A(G8_SA(0, 1), a2, 1);
            G8_WAIT_V(8); G8_WAIT_L(0); G8_BAR; G8_MMA(0, 0, At, B0); G8_MMA(0, 1, At, B1); G8_BAR; G8_SCHED;
            G8_LDA(At, 1, 1); G8_STAGE(G8_SB(1, 0), b3, voffB); G8_STAGE(G8_SB(1, 1), b3 + hstep, voffB); G8_STAGE_A(G8_SA(1, 0), a3, 0);
            G8_WAIT_V(8); G8_WAIT_L(0); G8_BAR; G8_MMA(1, 0, At, B0); G8_MMA(1, 1, At, B1); G8_BAR; G8_SCHED;
        }
        if (wr == 0) G8_BAR;
        E(acc, cur, wr, wc, fr, fq);
        if (!has_next) break;
#pragma unroll
        for (int a = 0; a < 2; ++a)
#pragma unroll
            for (int b = 0; b < 2; ++b)
#pragma unroll
                for (int m = 0; m < 4; ++m)
#pragma unroll
                    for (int n = 0; n < 2; ++n) acc[a][b][m][n] = (f32x4){0.f, 0.f, 0.f, 0.f};
        cur = nxt; cA = nA; cB = nB; ++ui;
        if (wr == 1) G8_BAR;
    }
    G8_WAIT_V(0);
    G8_BAR;
#undef G8_SA
#undef G8_SB
#undef G8_STAGE
#undef G8_STAGE_A
#undef G8_LDA
#undef G8_LDB
#undef G8_MMA
#undef G8_WAIT_V
#undef G8_WAIT_L
#undef G8_BAR
#undef G8_SCHED
}

struct DenseSched {
    const char* A; const char* Bt; char* O; int K, nM, nN, nwg, G, c, ldo, obytes;
    __device__ __forceinline__ void init(const void* A_, const void* Bt_, void* O_, int M, int N, int K_, int ldo_, int obytes_, int G_, int c_) {
        A = (const char*)A_; Bt = (const char*)Bt_; O = (char*)O_; K = K_; nM = M / BM; nN = N / BM; nwg = nM * nN; G = G_; c = c_; ldo = ldo_; obytes = obytes_; }
    __device__ __forceinline__ bool next(int i, UnitG& u) const {
        const long L = (long)i * G + c; if (L >= nwg) return false;
        int wgid = (int)L; { const int q = nwg / NXCD, r = nwg % NXCD, xcd = wgid % NXCD, off = wgid / NXCD; wgid = (xcd < r ? xcd * (q + 1) : r * (q + 1) + (xcd - r) * q) + off; }
        const int nig = WGM * nN, gid = wgid / nig, fm = gid * WGM, gsz = (nM - fm) < WGM ? (nM - fm) : WGM;
        const int pm = fm + ((wgid % nig) % gsz), pn = (wgid % nig) / gsz;
        u.p0 = pm; u.p1 = pn; u.p2 = 0; u.A = A + (size_t)pm * BM * K * 2; u.B = Bt + (size_t)pn * BM * K * 2;
        u.O = O + (size_t)pm * BM * ldo + (size_t)pn * BM * obytes; u.ldo = ldo; return true;
    }
    static constexpr bool GATHER = false;
    __device__ __forceinline__ int pitch() const { return K * 2; }
    __device__ __forceinline__ unsigned aoff(int, int row, int cb) const { return (unsigned)(row * K * 2 + cb); }
};
struct EpiBf16 {
    static constexpr bool PERM = true;
    __device__ __forceinline__ void operator()(const f32x4 (&acc)[2][2][4][2], const UnitG& u, int wr, int wc, int fr, int fq) const {
        asm volatile("" : "+v"(fr), "+v"(fq));
#pragma unroll
        for (int ai = 0; ai < 2; ++ai)
#pragma unroll
            for (int m = 0; m < 4; ++m) { char* rowp = u.O + (size_t)(ai * HALF + wr * 64 + m * 16 + fr) * u.ldo + (wc * 32 + 8 * fq) * 2;
#pragma unroll
                for (int bj = 0; bj < 2; ++bj) { const f32x4 v0 = acc[ai][bj][m][0], v1 = acc[ai][bj][m][1];
                    u32x4 w; w.x = cvt_pk_bf16(v0[0], v0[1]); w.y = cvt_pk_bf16(v0[2], v0[3]); w.z = cvt_pk_bf16(v1[0], v1[1]); w.w = cvt_pk_bf16(v1[2], v1[3]);
                    *(u32x4*)(rowp + bj * HALF * 2) = w; } }
    }
};
struct EpiF32 {
    static constexpr bool PERM = false;
    __device__ __forceinline__ void operator()(const f32x4 (&acc)[2][2][4][2], const UnitG& u, int wr, int wc, int fr, int fq) const {
        asm volatile("" : "+v"(fr), "+v"(fq));
#pragma unroll
        for (int ai = 0; ai < 2; ++ai)
#pragma unroll
            for (int m = 0; m < 4; ++m) { char* rowp = u.O + (size_t)(ai * HALF + wr * 64 + m * 16 + fr) * u.ldo + (wc * 32 + 4 * fq) * 4;
#pragma unroll
                for (int bj = 0; bj < 2; ++bj)
#pragma unroll
                    for (int n = 0; n < 2; ++n) *(f32x4*)(rowp + (bj * HALF + n * 16) * 4) = acc[ai][bj][m][n]; }
    }
};
struct EpiH {
    static constexpr bool PERM = true;
    __device__ __forceinline__ void operator()(const f32x4 (&acc)[2][2][4][2], const UnitG& u, int wr, int wc, int fr, int fq) const {
        asm volatile("" : "+v"(fr), "+v"(fq));
        const int valid = u.p1;
#pragma unroll
        for (int ai = 0; ai < 2; ++ai)
#pragma unroll
            for (int m = 0; m < 4; ++m) { const int r = ai * HALF + wr * 64 + m * 16 + fr;
                if (r < valid) {
                    const f32x4 g0 = acc[ai][0][m][0], g1 = acc[ai][0][m][1], u0 = acc[ai][1][m][0], u1 = acc[ai][1][m][1];
                    float h[8];
#pragma unroll
                    for (int j = 0; j < 4; ++j) { h[j] = siluf_(g0[j]) * u0[j]; h[4 + j] = siluf_(g1[j]) * u1[j]; }
                    *(u32x4*)(u.O + (size_t)r * u.ldo + (wc * 32 + 8 * fq) * 2) = pack8(h); } }
    }
};
struct EpiY {
    static constexpr bool PERM = true;
    const float* sgate;
    __device__ __forceinline__ void operator()(const f32x4 (&acc)[2][2][4][2], const UnitG& u, int wr, int wc, int fr, int fq) const {
        asm volatile("" : "+v"(fr), "+v"(fq));
        const int valid = u.p1, slot0 = u.p0; const bool shared = u.p2 != 0;
#pragma unroll
        for (int ai = 0; ai < 2; ++ai)
#pragma unroll
            for (int m = 0; m < 4; ++m) { const int r = ai * HALF + wr * 64 + m * 16 + fr;
                if (r < valid) {
                    const float gt = shared ? 1.0f : sgate[slot0 + r];
                    char* rowp = u.O + (size_t)r * u.ldo + (wc * 32 + 8 * fq) * 2;
#pragma unroll
                    for (int bj = 0; bj < 2; ++bj) { const f32x4 v0 = acc[ai][bj][m][0] * gt, v1 = acc[ai][bj][m][1] * gt;
                        u32x4 w; w.x = cvt_pk_bf16(v0[0], v0[1]); w.y = cvt_pk_bf16(v0[2], v0[3]); w.z = cvt_pk_bf16(v1[0], v1[1]); w.w = cvt_pk_bf16(v1[2], v1[3]);
                        *(u32x4*)(rowp + bj * HALF * 2) = w; } } }
    }
};
}

template <int OFF> __device__ __forceinline__ unsigned long long karg64() {
    unsigned long long v;
    asm volatile("s_load_dwordx2 %0, %1, %2\n\ts_waitcnt lgkmcnt(0)" : "=&s"(v) : "s"((unsigned long long)__builtin_amdgcn_kernarg_segment_ptr()), "n"(OFF) : "memory");
    return v;
}
template <int OFF> __device__ __forceinline__ int karg32() {
    int v;
    asm volatile("s_load_dword %0, %1, %2\n\ts_waitcnt lgkmcnt(0)" : "=&s"(v) : "s"((unsigned long long)__builtin_amdgcn_kernarg_segment_ptr()), "n"(OFF) : "memory");
    return v;
}
#define KIN(k) ((const float*)karg64<8 * (k)>())
#define KOUT() ((float*)karg64<176>())
#define KWS() ((unsigned char*)karg64<184>())
struct Args { const float* in[22]; float* out; unsigned char* ws; int ph_lo, ph_hi, li, pad; };
struct Frame {
    LAS unsigned char* lds;
    int tid, lane, wave, vcu, G;
};
static_assert(offsetof(Args, out) == 176 && offsetof(Args, ws) == 184 && offsetof(Args, ph_lo) == 192 && offsetof(Args, ph_hi) == 196, "Args layout");

enum { GT_BASE = 0, GT_N = 1, GT_TOT0 = 2, GT_YB0 = 3, GT_YB1 = 4, GT_TS1 = 5, GT_TS20 = 6, GT_TS21 = 7 };

__device__ __forceinline__ void tr_item(const float* W, int ldw, int k0, int c0, bf16* WT, int ldt, int drow0, LAS float* scr, int lane) {
#pragma unroll 8
    for (int i = 0; i < 32; ++i) { const int kk = 2 * i + (lane >> 5); scr[kk * 33 + (lane & 31)] = W[(size_t)(k0 + kk) * ldw + c0 + (lane & 31)]; }
    LDS_WAIT(); asm volatile("" ::: "memory");
    const int c = lane & 7;
#pragma unroll
    for (int j = 0; j < 4; ++j) { const int n = (lane >> 3) + 8 * j; const LAS float* s = scr + (8 * c) * 33 + n;
        u32x4 o; o.x = cvt_pk_bf16(s[0 * 33], s[1 * 33]); o.y = cvt_pk_bf16(s[2 * 33], s[3 * 33]); o.z = cvt_pk_bf16(s[4 * 33], s[5 * 33]); o.w = cvt_pk_bf16(s[6 * 33], s[7 * 33]);
        *(u32x4*)(WT + (size_t)(drow0 + n) * ldt + k0 + 8 * c) = o; }
    LDS_WAIT(); asm volatile("" ::: "memory");
}
__device__ __forceinline__ void p0_prologue(Frame& F) {
    unsigned char* const ws_ = KWS(); float* const out_ = KOUT(); (void)ws_; (void)out_;
    const float* x = KIN(0); const float* meta = KIN(1); const float* w_in = KIN(2);
    LAS float* wbd = (LAS float*)(F.lds);
    LAS float* scr = (LAS float*)(F.lds + 32768 + F.wave * 8704);
    for (int i = F.tid; i < 8 * 1024; i += NTHREADS) { const int c = i >> 10, k = i & 1023; wbd[i] = w_in[(size_t)k * INC + NPJ + c]; }
    __syncthreads();
    const int gw = F.vcu * NWAVES + F.wave, NGW = F.G * NWAVES;
    bf16* xb = (bf16*)(ws_ + WS_RA); float* bd = (float*)(ws_ + TB_BD);
    for (int t = gw; t < T; t += NGW) {
        const f32x4* xr = (const f32x4*)(x + (size_t)t * D) + F.lane;
        f32x4 v[4];
#pragma unroll
        for (int j = 0; j < 4; ++j) v[j] = xr[64 * j];
        u32x2* o8 = (u32x2*)(xb + (size_t)t * D) + F.lane;
#pragma unroll
        for (int j = 0; j < 4; ++j) { u32x2 w; w.x = cvt_pk_bf16(v[j].x, v[j].y); w.y = cvt_pk_bf16(v[j].z, v[j].w); o8[64 * j] = w; }
        float s[8];
#pragma unroll
        for (int c = 0; c < 8; ++c) { float acc = 0.f;
#pragma unroll
            for (int j = 0; j < 4; ++j) { const f32x4 w = *(const LAS f32x4*)(wbd + c * 1024 + 256 * j + 4 * F.lane); acc += v[j].x * w.x + v[j].y * w.y + v[j].z * w.z + v[j].w * w.w; }
            s[c] = wave_sum(acc); }
        if (F.lane < 8) { float r = s[0];
#pragma unroll
            for (int c = 1; c < 8; ++c) r = (F.lane == c) ? s[c] : r;
            bd[(size_t)t * 8 + F.lane] = r; }
    }
    bf16* WinT = (bf16*)(ws_ + W_WINT); bf16* WoutT = (bf16*)(ws_ + W_WOUTT); bf16* WrT = (bf16*)(ws_ + W_WRT); bf16* Wsgu = (bf16*)(ws_ + W_WSGU); bf16* Wsd = (bf16*)(ws_ + W_WSD);
    constexpr int I_IN = 16 * 112, I_OUT = 16 * 32, I_R = 16 * 8, I_SG = 16 * 8, I_SU = 16 * 8, I_SD = 4 * 32;
    constexpr int NITEMS = I_IN + I_OUT + I_R + I_SG + I_SU + I_SD;
    for (int it = gw; it < NITEMS; it += NGW) {
        int r = it;
        if (r < I_IN) { const int kb = r / 112, nb = r % 112; tr_item(w_in, INC, 64 * kb, 32 * nb, WinT, D, 32 * nb, scr, F.lane); continue; } r -= I_IN;
        if (r < I_OUT) { const int kb = r / 32, nb = r % 32; tr_item(KIN(9), D, 64 * kb, 32 * nb, WoutT, D, 32 * nb, scr, F.lane); continue; } r -= I_OUT;
        if (r < I_R) { const int kb = r / 8, nb = r % 8; tr_item(KIN(12), NE, 64 * kb, 32 * nb, WrT, D, 32 * nb, scr, F.lane); continue; } r -= I_R;
        if (r < I_SG) { const int kb = r / 8, nb = r % 8; tr_item(KIN(17), EFF, 64 * kb, 32 * nb, Wsgu, D, 256 * (nb >> 2) + 32 * (nb & 3), scr, F.lane); continue; } r -= I_SG;
        if (r < I_SU) { const int kb = r / 8, nb = r % 8; tr_item(KIN(18), EFF, 64 * kb, 32 * nb, Wsgu, D, 256 * (nb >> 2) + 128 + 32 * (nb & 3), scr, F.lane); continue; } r -= I_SU;
        { const int kb = r / 32, nb = r % 32; tr_item(KIN(19), D, 64 * kb, 32 * nb, Wsd, EFF, 32 * nb, scr, F.lane); }
    }
    float* projm = (float*)(ws_ + TB_PROJM);
    for (int idx = F.vcu * NTHREADS + F.tid; idx < INC * 4; idx += F.G * NTHREADS) {
        const int col = idx % INC, rg = idx / INC;
        float acc[4] = {0.f, 0.f, 0.f, 0.f};
        for (int k = 0; k < D; ++k) { const float w = w_in[(size_t)k * INC + col];
#pragma unroll
            for (int r = 0; r < 4; ++r) acc[r] += meta[(rg * 4 + r) * D + k] * w; }
#pragma unroll
        for (int r = 0; r < 4; ++r) projm[(rg * 4 + r) * INC + col] = acc[r];
    }
}

__device__ __forceinline__ void p2_ld8(const bf16* proj, const float* projm, bool metarun, int b, int pos, int col, float (&o)[8]) {
    if (pos < 0 && metarun) {
#pragma unroll
        for (int j = 0; j < 8; ++j) o[j] = 0.f;
        return; }
    if (pos < 0 || metarun) { const int p = metarun ? pos : 16 + pos; const f32x4* s = (const f32x4*)(projm + (size_t)p * INC + col); const f32x4 a0 = s[0], a1 = s[1];
        o[0] = a0.x; o[1] = a0.y; o[2] = a0.z; o[3] = a0.w; o[4] = a1.x; o[5] = a1.y; o[6] = a1.z; o[7] = a1.w; return; }
    const u32x4 w = *(const u32x4*)(proj + (size_t)(b * SEQ + pos) * NPJ + col); unpack8(w, o);
}
__device__ __forceinline__ void p2_prep(Frame& F) {
    unsigned char* const ws_ = KWS(); float* const out_ = KOUT(); (void)ws_; (void)out_;
    const bf16* proj = (const bf16*)(ws_ + WS_RB); const float* projm = (const float*)(ws_ + TB_PROJM); const float* bd = (const float*)(ws_ + TB_BD);
    bf16* ycat = (bf16*)(ws_ + WS_RA); bf16* qn = (bf16*)(ws_ + WS_QN); bf16* kn = (bf16*)(ws_ + WS_KN); bf16* vv = (bf16*)(ws_ + WS_VV); bf16* zb = (bf16*)(ws_ + WS_ZB);
    float* betab = (float*)(ws_ + TB_BETA); float* gb = (float*)(ws_ + TB_G);
    bf16* mq = (bf16*)(ws_ + TB_METAQ); bf16* mk = (bf16*)(ws_ + TB_METAK); bf16* mv = (bf16*)(ws_ + TB_METAV); float* mbeta = (float*)(ws_ + TB_METAB); float* mg = (float*)(ws_ + TB_METAG);
    const float* conv_w = KIN(3); const float* conv_nw = KIN(4); const float* gconv_w = KIN(5); const float* a_log = KIN(6); const float* dt_bias = KIN(7);
    const int gw = F.vcu * NWAVES + F.wave, NGW = F.G * NWAVES, lane = F.lane, ch = 8 * lane;
    for (int rid = gw; rid < 2049; rid += NGW) {
        const bool metarun = (rid == 2048);
        const int b = metarun ? 0 : (rid >> 6), s0 = metarun ? 0 : (rid & 63) * 32, len = metarun ? 16 : 32;
        if (metarun) {
            for (int r = 0; r < 48; ++r) { const u32x4 z = (u32x4){0u, 0u, 0u, 0u}; *(u32x4*)(mq + r * 512 + ch) = z; *(u32x4*)(mk + r * 512 + ch) = z; *(u32x4*)(mv + r * 512 + ch) = z; }
            for (int i = lane; i < 48 * 4; i += 64) { mbeta[i] = 0.f; mg[i] = 0.f; }
        }
        if (!metarun) {
            float w0[8], w1[8], w2[8], nw[8];
#pragma unroll
            for (int j = 0; j < 8; ++j) { w0[j] = conv_w[ch + j]; w1[j] = conv_w[CW + ch + j]; w2[j] = conv_w[2 * CW + ch + j]; nw[j] = conv_nw[ch + j]; }
            float c2[8], c1[8], c0[8], t0[8], t1[8];
            p2_ld8(proj, projm, false, b, s0 - 2, CW + ch, t0); p2_ld8(proj, projm, false, b, s0 - 2, 2 * CW + ch, t1);
#pragma unroll
            for (int j = 0; j < 8; ++j) c2[j] = t0[j] * t1[j];
            p2_ld8(proj, projm, false, b, s0 - 1, CW + ch, t0); p2_ld8(proj, projm, false, b, s0 - 1, 2 * CW + ch, t1);
#pragma unroll
            for (int j = 0; j < 8; ++j) c1[j] = t0[j] * t1[j];
            for (int s = s0; s < s0 + len; ++s) {
                float gbv[8], y[8];
                p2_ld8(proj, projm, false, b, s, CW + ch, t0); p2_ld8(proj, projm, false, b, s, 2 * CW + ch, t1); p2_ld8(proj, projm, false, b, s, ch, gbv);
                float ss = 0.f;
#pragma unroll
                for (int j = 0; j < 8; ++j) { c0[j] = t0[j] * t1[j]; y[j] = gbv[j] * (w0[j] * c2[j] + w1[j] * c1[j] + w2[j] * c0[j]); ss += y[j] * y[j]; c2[j] = c1[j]; c1[j] = c0[j]; }
                ss = wave_sum(ss);
                const float rms = 1.0f / sqrtf(ss * (1.0f / CW) + EPS);
#pragma unroll
                for (int j = 0; j < 8; ++j) y[j] = y[j] * rms * nw[j];
                *(u32x4*)(ycat + (size_t)(b * SEQ + s) * D + ch) = pack8(y);
                if (DBG_STAGE == 4) *(u32x4*)(ycat + (size_t)(b * SEQ + s) * D + CW + ch) = (u32x4){0u, 0u, 0u, 0u};
                *(u32x4*)(zb + (size_t)(b * SEQ + s) * GWID + ch) = *(const u32x4*)(proj + (size_t)(b * SEQ + s) * NPJ + 3072 + ch);
            }
        }
#pragma unroll 1
        for (int p = 0; p < 3; ++p) {
            const int cb = 1536 + 512 * p + ch;
            float w0[8], w1[8], w2[8], w3[8];
#pragma unroll
            for (int j = 0; j < 8; ++j) { w0[j] = gconv_w[512 * p + ch + j]; w1[j] = gconv_w[1536 + 512 * p + ch + j]; w2[j] = gconv_w[2 * 1536 + 512 * p + ch + j]; w3[j] = gconv_w[3 * 1536 + 512 * p + ch + j]; }
            float r3[8], r2[8], r1[8], r0[8];
            p2_ld8(proj, projm, metarun, b, s0 - 3, cb, r3); p2_ld8(proj, projm, metarun, b, s0 - 2, cb, r2); p2_ld8(proj, projm, metarun, b, s0 - 1, cb, r1);
            bf16* dst = metarun ? (p == 0 ? mq : (p == 1 ? mk : mv)) : (p == 0 ? qn : (p == 1 ? kn : vv));
            for (int s = s0; s < s0 + len; ++s) {
                p2_ld8(proj, projm, metarun, b, s, cb, r0);
                float y[8]; float ss = 0.f;
#pragma unroll
                for (int j = 0; j < 8; ++j) { const float c = w0[j] * r3[j] + w1[j] * r2[j] + w2[j] * r1[j] + w3[j] * r0[j]; y[j] = siluf_(c); ss += y[j] * y[j]; r3[j] = r2[j]; r2[j] = r1[j]; r1[j] = r0[j]; }
                if (p < 2) {
                    ss += __shfl_xor(ss, 1); ss += __shfl_xor(ss, 2); ss += __shfl_xor(ss, 4); ss += __shfl_xor(ss, 8);
                    const float sc = (1.0f / sqrtf(ss + 1e-6f)) * (p == 0 ? 0.08838834764831845f : 1.0f);
#pragma unroll
                    for (int j = 0; j < 8; ++j) y[j] *= sc;
                }
                const size_t row = metarun ? (size_t)(48 + s) : (size_t)(b * SEQ + s);
                *(u32x4*)(dst + row * GWID + ch) = pack8(y);
            }
        }
        for (int i = lane; i < len * 8; i += 64) {
            const int s = s0 + (i >> 3), c = i & 7, h = c & 3;
            const float v = metarun ? projm[(size_t)s * INC + NPJ + c] : bd[(size_t)(b * SEQ + s) * 8 + c];
            const size_t row = metarun ? (size_t)(48 + s) : (size_t)(b * SEQ + s);
            if (c < 4) { const float be = 1.0f / (1.0f + expf(-v)); (metarun ? mbeta : betab)[row * 4 + h] = be; }
            else { const float xx = v + dt_bias[h]; const float sp = fmaxf(xx, 0.f) + log1pf(expf(-fabsf(xx))); (metarun ? mg : gb)[row * 4 + h] = -expf(a_log[h]) * sp; }
        }
    }
}

__device__ __forceinline__ int perm_pos(int d) { return (d & ~31) | (((d >> 2) & 3) << 3) | (((d >> 4) & 1) << 2) | (d & 3); }
constexpr int P3_QT = 0, P3_KT = 17408, P3_LT = 34816, P3_SC = 51200, P3_OUT = 52224;
__device__ __forceinline__ void p3_gdn_local(Frame& F) {
    unsigned char* const ws_ = KWS(); float* const out_ = KOUT(); (void)ws_; (void)out_;
    LAS unsigned char* lds = F.lds;
    const int tid = F.tid, lane = F.lane, wave = F.wave;
    LAS float* sc_gc = (LAS float*)(lds + P3_SC);
    LAS float* sc_beta = sc_gc + 64;
    LAS float* sc_g = sc_gc + 128;
    LAS float* LT = (LAS float*)(lds + P3_LT);
    for (int unit = F.vcu; unit < 4100; unit += F.G) {
        const bool metau = unit >= 4096;
        const int h = unit & 3, bc = unit >> 2;
        const size_t row0 = metau ? 0 : (size_t)bc * 64;
        const bf16* qp = metau ? (const bf16*)(ws_ + TB_METAQ) : (const bf16*)(ws_ + WS_QN);
        const bf16* kp = metau ? (const bf16*)(ws_ + TB_METAK) : (const bf16*)(ws_ + WS_KN);
        const bf16* vp = metau ? (const bf16*)(ws_ + TB_METAV) : (const bf16*)(ws_ + WS_VV);
        const float* gp = metau ? (const float*)(ws_ + TB_METAG) : (const float*)(ws_ + TB_G);
        const float* bp = metau ? (const float*)(ws_ + TB_METAB) : (const float*)(ws_ + TB_BETA);
        unsigned char* blk = ws_ + WS_RB + (size_t)unit * GBLK;
#pragma unroll
        for (int i = 0; i < 2; ++i) { const int p = tid + 512 * i, r = p >> 4, c16 = p & 15;
            *(LAS u32x4*)(lds + P3_QT + r * 272 + c16 * 16) = *(const u32x4*)(qp + (row0 + r) * GWID + h * HD + c16 * 8);
            *(LAS u32x4*)(lds + P3_KT + r * 272 + c16 * 16) = *(const u32x4*)(kp + (row0 + r) * GWID + h * HD + c16 * 8); }
        if (tid < 64) sc_g[tid] = gp[(row0 + tid) * 4 + h];
        else if (tid < 128) sc_beta[tid - 64] = bp[(row0 + tid - 64) * 4 + h];
        __syncthreads();
        float gcl = sc_g[lane];
#pragma unroll
        for (int o = 1; o < 64; o <<= 1) { const float y = __shfl_up(gcl, o); if (lane >= o) gcl += y; }
        sc_gc[lane] = gcl;
        LDS_WAIT(); asm volatile("" ::: "memory");
        const float glast = __shfl(gcl, 63);
        {
            const int fr = lane & 15, fq = lane >> 4, mt = wave >> 1;
#pragma unroll
            for (int tn = 0; tn < 2; ++tn) {
                const int ntl = 2 * (wave & 1) + tn;
                f32x4 akk = (f32x4){0.f, 0.f, 0.f, 0.f}, aqk = (f32x4){0.f, 0.f, 0.f, 0.f};
#pragma unroll
                for (int s = 0; s < 4; ++s) {
                    const bf16x8 ki = *(const LAS bf16x8*)(lds + P3_KT + (16 * mt + fr) * 272 + (32 * s + 8 * fq) * 2);
                    const bf16x8 qi = *(const LAS bf16x8*)(lds + P3_QT + (16 * mt + fr) * 272 + (32 * s + 8 * fq) * 2);
                    const bf16x8 kj = *(const LAS bf16x8*)(lds + P3_KT + (16 * ntl + fr) * 272 + (32 * s + 8 * fq) * 2);
                    akk = __builtin_amdgcn_mfma_f32_16x16x32_bf16(ki, kj, akk, 0, 0, 0);
                    aqk = __builtin_amdgcn_mfma_f32_16x16x32_bf16(qi, kj, aqk, 0, 0, 0);
                }
                const int j = 16 * ntl + fr; const float gcj = sc_gc[j];
                f32x4 lv;
#pragma unroll
                for (int jj = 0; jj < 4; ++jj) { const int i = 16 * mt + 4 * fq + jj; const float dec = fast_exp(fminf(sc_gc[i] - gcj, 0.f));
                    lv[jj] = (i > j) ? sc_beta[i] * akk[jj] * dec : 0.f;
                    const float at = (i >= j) ? aqk[jj] * dec : 0.f;
                    *(LAS bf16*)(lds + P3_OUT + GB_ATT + i * 144 + perm_pos(j) * 2) = (bf16)(cvt_pk_bf16(at, 0.f) & 0xffffu); }
                *(LAS f32x4*)(LT + j * 64 + 16 * mt + 4 * fq) = lv;
            }
        }
        __syncthreads();
        if (tid < 256) {
            float r[64];
            if (tid < 128) {
#pragma unroll
                for (int i = 0; i < 64; ++i) r[i] = sc_beta[i] * bf2f(vp[(row0 + i) * GWID + h * HD + tid]);
            } else {
#pragma unroll
                for (int i = 0; i < 64; ++i) r[i] = sc_beta[i] * fast_exp(sc_gc[i]) * bf2f(*(const LAS bf16*)(lds + P3_KT + i * 272 + (tid - 128) * 2));
            }
#pragma unroll
            for (int j = 0; j < 63; ++j) {
                const float xj = r[j];
#pragma unroll
                for (int i4 = ((j + 1) & ~3); i4 < 64; i4 += 4) {
                    const f32x4 l = *(const LAS f32x4*)(LT + j * 64 + i4);
                    r[i4 + 0] -= l.x * xj; r[i4 + 1] -= l.y * xj; r[i4 + 2] -= l.z * xj; r[i4 + 3] -= l.w * xj;
                }
            }
            if (tid < 128) {
#pragma unroll
                for (int c8 = 0; c8 < 8; ++c8) { u32x4 w; w.x = cvt_pk_bf16(r[8 * c8 + 0], r[8 * c8 + 1]); w.y = cvt_pk_bf16(r[8 * c8 + 2], r[8 * c8 + 3]); w.z = cvt_pk_bf16(r[8 * c8 + 4], r[8 * c8 + 5]); w.w = cvt_pk_bf16(r[8 * c8 + 6], r[8 * c8 + 7]);
                    *(LAS u32x4*)(lds + P3_OUT + GB_UT + tid * 144 + c8 * 16) = w; }
            } else {
                const int pos = perm_pos(tid - 128);
#pragma unroll
                for (int c = 0; c < 64; ++c) *(LAS bf16*)(lds + P3_OUT + GB_WP + c * 272 + pos * 2) = (bf16)(cvt_pk_bf16(-r[c], 0.f) & 0xffffu);
            }
        } else {
            const int tt = tid - 256;
            {
                const int c = tt >> 2, s = tt & 3; const float e = fast_exp(sc_gc[c]);
                float v[32];
#pragma unroll
                for (int g4 = 0; g4 < 4; ++g4) { const u32x4 w = *(const LAS u32x4*)(lds + P3_QT + c * 272 + (32 * s + 8 * g4) * 2); float t8[8]; unpack8(w, t8);
#pragma unroll
                    for (int j = 0; j < 8; ++j) v[8 * g4 + j] = t8[j] * e; }
#pragma unroll
                for (int q = 0; q < 4; ++q) { float o8[8];
#pragma unroll
                    for (int j = 0; j < 8; ++j) o8[j] = v[16 * (j >> 2) + 4 * q + (j & 3)];
                    *(LAS u32x4*)(lds + P3_OUT + GB_QD + c * 272 + (32 * s + 8 * q) * 2) = pack8(o8); }
            }
            {
                const int dk = tt >> 1, s = tt & 1;
                float v[32];
#pragma unroll
                for (int i = 0; i < 32; ++i) { const int c = 32 * s + i; v[i] = bf2f(*(const LAS bf16*)(lds + P3_KT + c * 272 + dk * 2)) * fast_exp(glast - sc_gc[c]); }
#pragma unroll
                for (int q = 0; q < 4; ++q) { float o8[8];
#pragma unroll
                    for (int j = 0; j < 8; ++j) o8[j] = v[16 * (j >> 2) + 4 * q + (j & 3)];
                    *(LAS u32x4*)(lds + P3_OUT + GB_KDT + dk * 144 + (32 * s + 8 * q) * 2) = pack8(o8); }
            }
        }
        __syncthreads();
        for (int p = tid; p < GB_EG / 16; p += NTHREADS) *(u32x4*)(blk + p * 16) = *(const LAS u32x4*)(lds + P3_OUT + p * 16);
        if (tid == 0) *(float*)(blk + GB_EG) = fast_exp(glast);
        __syncthreads();
    }
}

constexpr int P4_IN = 0, P4_OT = 81920;
__device__ __forceinline__ void p4_gdn_scan(Frame& F) {
    unsigned char* const ws_ = KWS(); float* const out_ = KOUT(); (void)ws_; (void)out_;
    if (F.vcu >= BATCH * NHEAD) return;
    LAS unsigned char* lds = F.lds;
    const int tid = F.tid, lane = F.lane, wv = F.wave, fr = lane & 15, fq = lane >> 4;
    const int b = F.vcu >> 2, h = F.vcu & 3;
    const float* gnw = KIN(8);
    const bf16* zb = (const bf16*)(ws_ + WS_ZB); bf16* ycat = (bf16*)(ws_ + WS_RA);
    const unsigned char* gbase = ws_ + WS_RB;
    f32x4 S[8]; bf16x8 Sb[4];
#pragma unroll
    for (int i = 0; i < 8; ++i) S[i] = (f32x4){0.f, 0.f, 0.f, 0.f};
#pragma unroll
    for (int i = 0; i < 4; ++i) Sb[i] = (bf16x8){0, 0, 0, 0, 0, 0, 0, 0};
    constexpr int NPIECE = GBLK / 16;
    u32x4 pre[10];
    {
        const unsigned char* blk = gbase + (size_t)(4096 + h) * GBLK;
#pragma unroll
        for (int i = 0; i < 10; ++i) pre[i] = *(const u32x4*)(blk + (size_t)(tid + 512 * i) * 16);
#pragma unroll
        for (int i = 0; i < 10; ++i) *(LAS u32x4*)(lds + P4_IN + (tid + 512 * i) * 16) = pre[i];
    }
    __syncthreads();
    for (int n = 0; n <= 32; ++n) {
        if (n < 32) {
            const unsigned char* blk = gbase + (size_t)(((b * 32 + n) * 4) + h) * GBLK;
#pragma unroll
            for (int i = 0; i < 10; ++i) pre[i] = *(const u32x4*)(blk + (size_t)(tid + 512 * i) * 16);
        }
        const float eg = *(const LAS float*)(lds + P4_IN + GB_EG);
        f32x4 o[4], v[4];
#pragma unroll
        for (int mt = 0; mt < 4; ++mt) { o[mt] = (f32x4){0.f, 0.f, 0.f, 0.f};
            const u32x2 w = *(const LAS u32x2*)(lds + P4_IN + GB_UT + (16 * wv + fr) * 144 + (16 * mt + 4 * fq) * 2);
            v[mt] = (f32x4){bf_lo(w.x), bf_hi(w.x), bf_lo(w.y), bf_hi(w.y)}; }
#pragma unroll
        for (int s = 0; s < 4; ++s)
#pragma unroll
            for (int mt = 0; mt < 4; ++mt) {
                const bf16x8 aw = *(const LAS bf16x8*)(lds + P4_IN + GB_WP + (16 * mt + fr) * 272 + (32 * s + 8 * fq) * 2);
                const bf16x8 aq = *(const LAS bf16x8*)(lds + P4_IN + GB_QD + (16 * mt + fr) * 272 + (32 * s + 8 * fq) * 2);
                v[mt] = __builtin_amdgcn_mfma_f32_16x16x32_bf16(aw, Sb[s], v[mt], 0, 0, 0);
                o[mt] = __builtin_amdgcn_mfma_f32_16x16x32_bf16(aq, Sb[s], o[mt], 0, 0, 0);
            }
        bf16x8 vb[2];
#pragma unroll
        for (int s2 = 0; s2 < 2; ++s2) { u32x4 w; w.x = cvt_pk_bf16(v[2 * s2][0], v[2 * s2][1]); w.y = cvt_pk_bf16(v[2 * s2][2], v[2 * s2][3]); w.z = cvt_pk_bf16(v[2 * s2 + 1][0], v[2 * s2 + 1][1]); w.w = cvt_pk_bf16(v[2 * s2 + 1][2], v[2 * s2 + 1][3]);
            vb[s2] = __builtin_bit_cast(bf16x8, w); }
#pragma unroll
        for (int s2 = 0; s2 < 2; ++s2)
#pragma unroll
            for (int mt = 0; mt < 4; ++mt) {
                const bf16x8 at = *(const LAS bf16x8*)(lds + P4_IN + GB_ATT + (16 * mt + fr) * 144 + (32 * s2 + 8 * fq) * 2);
                o[mt] = __builtin_amdgcn_mfma_f32_16x16x32_bf16(at, vb[s2], o[mt], 0, 0, 0);
            }
#pragma unroll
        for (int dt = 0; dt < 8; ++dt) { S[dt] = S[dt] * eg;
#pragma unroll
            for (int s2 = 0; s2 < 2; ++s2) {
                const bf16x8 ak = *(const LAS bf16x8*)(lds + P4_IN + GB_KDT + (16 * dt + fr) * 144 + (32 * s2 + 8 * fq) * 2);
                S[dt] = __builtin_amdgcn_mfma_f32_16x16x32_bf16(ak, vb[s2], S[dt], 0, 0, 0);
            } }
#pragma unroll
        for (int s = 0; s < 4; ++s) { u32x4 w; w.x = cvt_pk_bf16(S[2 * s][0], S[2 * s][1]); w.y = cvt_pk_bf16(S[2 * s][2], S[2 * s][3]); w.z = cvt_pk_bf16(S[2 * s + 1][0], S[2 * s + 1][1]); w.w = cvt_pk_bf16(S[2 * s + 1][2], S[2 * s + 1][3]);
            Sb[s] = __builtin_bit_cast(bf16x8, w); }
        if (n >= 1) {
#pragma unroll
            for (int mt = 0; mt < 4; ++mt)
#pragma unroll
                for (int jj = 0; jj < 4; ++jj) *(LAS float*)(lds + P4_OT + ((16 * mt + 4 * fq + jj) * 132 + 16 * wv + fr) * 4) = o[mt][jj];
        }
        __syncthreads();
        if (n >= 1) {
            const int row = tid >> 3, part = tid & 7;
            float ov[16]; float ss = 0.f;
#pragma unroll
            for (int q = 0; q < 4; ++q) { const f32x4 t4 = *(const LAS f32x4*)(lds + P4_OT + (row * 132 + 16 * part + 4 * q) * 4); ov[4 * q] = t4.x; ov[4 * q + 1] = t4.y; ov[4 * q + 2] = t4.z; ov[4 * q + 3] = t4.w; }
#pragma unroll
            for (int j = 0; j < 16; ++j) ss += ov[j] * ov[j];
            ss += __shfl_xor(ss, 1); ss += __shfl_xor(ss, 2); ss += __shfl_xor(ss, 4);
            const float rms = 1.0f / sqrtf(ss * (1.0f / HD) + EPS);
            const size_t t = (size_t)b * SEQ + 64 * (n - 1) + row;
            float z8[8];
#pragma unroll
            for (int hh = 0; hh < 2; ++hh) {
                unpack8(*(const u32x4*)(zb + t * GWID + h * HD + 16 * part + 8 * hh), z8);
                float o8[8];
#pragma unroll
                for (int j = 0; j < 8; ++j) { o8[j] = ov[8 * hh + j] * rms * gnw[16 * part + 8 * hh + j] * siluf_(z8[j]); if (DBG_STAGE == 5 && !(fabsf(o8[j]) < 1e30f)) o8[j] = 0.f; }
                *(u32x4*)(ycat + t * D + CW + h * HD + 16 * part + 8 * hh) = pack8(o8);
            }
        }
        if (n < 32) {
#pragma unroll
            for (int i = 0; i < 10; ++i) *(LAS u32x4*)(lds + P4_IN + (tid + 512 * i) * 16) = pre[i];
        }
        __syncthreads();
    }
}


#ifndef GDN_RECURRENT
#define GDN_RECURRENT 1
#endif
constexpr size_t WS_OBUF = WS_RB;
__device__ __forceinline__ void p3_gdn_recurrent(Frame& F) {
    unsigned char* const ws_ = KWS();
    LAS float* lk = (LAS float*)(F.lds); LAS float* lq = lk + 64 * 128; LAS float* lv = lq + 64 * 128; LAS float* lb = lv + 64 * 64; LAS float* lg = lb + 64;
    const int tid = F.tid, dvl = tid >> 3, part = tid & 7;
    const int b = F.vcu >> 3, h = (F.vcu >> 1) & 3, dvh = F.vcu & 1;
    float* obuf = (float*)(ws_ + WS_OBUF);
    float S[16];
#pragma unroll
    for (int i = 0; i < 16; ++i) S[i] = 0.f;
    for (int grp = 0; grp <= 32; ++grp) {
        const bool mg_ = (grp == 0); const int ntok = mg_ ? 16 : 64;
        const size_t row0 = mg_ ? 48 : (size_t)b * SEQ + 64 * (grp - 1);
        const bf16* qp = mg_ ? (const bf16*)(ws_ + TB_METAQ) : (const bf16*)(ws_ + WS_QN);
        const bf16* kp = mg_ ? (const bf16*)(ws_ + TB_METAK) : (const bf16*)(ws_ + WS_KN);
        const bf16* vp = mg_ ? (const bf16*)(ws_ + TB_METAV) : (const bf16*)(ws_ + WS_VV);
        const float* gp = mg_ ? (const float*)(ws_ + TB_METAG) : (const float*)(ws_ + TB_G);
        const float* bp = mg_ ? (const float*)(ws_ + TB_METAB) : (const float*)(ws_ + TB_BETA);
        __syncthreads();
        for (int i = tid; i < ntok * 128; i += NTHREADS) { const int r = i >> 7, c = i & 127; lk[i] = bf2f(kp[(row0 + r) * GWID + h * HD + c]); lq[i] = bf2f(qp[(row0 + r) * GWID + h * HD + c]); }
        for (int i = tid; i < ntok * 64; i += NTHREADS) { const int r = i >> 6, c = i & 63; lv[i] = bf2f(vp[(row0 + r) * GWID + h * HD + 64 * dvh + c]); }
        if (tid < ntok) { lb[tid] = bp[(row0 + tid) * 4 + h]; lg[tid] = gp[(row0 + tid) * 4 + h]; }
        __syncthreads();
        for (int s = 0; s < ntok; ++s) {
            const float a = expf(lg[s]), be = lb[s];
            float kk[16], qq[16];
#pragma unroll
            for (int i4 = 0; i4 < 4; ++i4) { const f32x4 t4 = *(const LAS f32x4*)(lk + s * 128 + 16 * part + 4 * i4); kk[4 * i4] = t4.x; kk[4 * i4 + 1] = t4.y; kk[4 * i4 + 2] = t4.z; kk[4 * i4 + 3] = t4.w;
                const f32x4 u4 = *(const LAS f32x4*)(lq + s * 128 + 16 * part + 4 * i4); qq[4 * i4] = u4.x; qq[4 * i4 + 1] = u4.y; qq[4 * i4 + 2] = u4.z; qq[4 * i4 + 3] = u4.w; }
            float r = 0.f;
#pragma unroll
            for (int i = 0; i < 16; ++i) r += S[i] * kk[i];
            r += __shfl_xor(r, 1); r += __shfl_xor(r, 2); r += __shfl_xor(r, 4);
            const float vn = be * (lv[s * 64 + dvl] - a * r);
            float o = 0.f;
#pragma unroll
            for (int i = 0; i < 16; ++i) { S[i] = a * S[i] + kk[i] * vn; o += S[i] * qq[i]; }
            o += __shfl_xor(o, 1); o += __shfl_xor(o, 2); o += __shfl_xor(o, 4);
            if (!mg_ && part == 0) obuf[(row0 + s) * GWID + h * HD + 64 * dvh + dvl] = o;
        }
    }
}
__device__ __forceinline__ void p4_gdn_gate(Frame& F) {
    unsigned char* const ws_ = KWS();
    const float* obuf = (const float*)(ws_ + WS_OBUF); const bf16* zb = (const bf16*)(ws_ + WS_ZB); bf16* ycat = (bf16*)(ws_ + WS_RA); const float* gnw = KIN(8);
    const int gw = F.vcu * NWAVES + F.wave, NGW = F.G * NWAVES, lane = F.lane;
    for (int it = gw; it < T * NHEAD; it += NGW) {
        const size_t t = it >> 2; const int h = it & 3;
        const f32x2 ov = *((const f32x2*)(obuf + t * GWID + h * HD) + lane);
        const float ss = wave_sum(ov.x * ov.x + ov.y * ov.y);
        const float rms = 1.0f / sqrtf(ss * (1.0f / HD) + EPS);
        const unsigned zw = *((const unsigned*)(zb + t * GWID + h * HD) + lane);
        const float o0 = ov.x * rms * gnw[2 * lane] * siluf_(bf_lo(zw)), o1 = ov.y * rms * gnw[2 * lane + 1] * siluf_(bf_hi(zw));
        *((unsigned*)(ycat + t * D + CW + h * HD) + lane) = cvt_pk_bf16(o0, o1);
    }
}

__device__ __forceinline__ void p6_ln1_and_wexp(Frame& F) {
    unsigned char* const ws_ = KWS(); float* const out_ = KOUT(); (void)ws_; (void)out_;
    const float* x = KIN(0); const float* g1 = KIN(10); const float* b1 = KIN(11);
    const bf16* mix = (const bf16*)(ws_ + WS_MIX);
    const int gw = F.vcu * NWAVES + F.wave, NGW = F.G * NWAVES, lane = F.lane;
    for (int t = gw; t < T; t += NGW) {
        const f32x4* xr = (const f32x4*)(x + (size_t)t * D) + lane; const u32x2* mr = (const u32x2*)(mix + (size_t)t * D) + lane;
        f32x4 v[4]; float s = 0.f;
#pragma unroll
        for (int j = 0; j < 4; ++j) { const f32x4 xv = xr[64 * j]; const u32x2 m = (DBG_STAGE == 3) ? (u32x2){0u, 0u} : mr[64 * j];
            v[j] = (f32x4){ALPHA * xv.x + bf_lo(m.x), ALPHA * xv.y + bf_hi(m.x), ALPHA * xv.z + bf_lo(m.y), ALPHA * xv.w + bf_hi(m.y)}; s += (v[j].x + v[j].y) + (v[j].z + v[j].w); }
        const float mean = wave_sum(s) * (1.f / D); float s2 = 0.f;
#pragma unroll
        for (int j = 0; j < 4; ++j) { v[j] = v[j] - mean; s2 += (v[j].x * v[j].x + v[j].y * v[j].y) + (v[j].z * v[j].z + v[j].w * v[j].w); }
        const float rstd = 1.f / sqrtf(wave_sum(s2) * (1.f / D) + EPS);
        u32x2* o8 = (u32x2*)((char*)out_ + (size_t)t * 4096) + lane;
#pragma unroll
        for (int j = 0; j < 4; ++j) { const f32x4 gg = *((const f32x4*)g1 + lane + 64 * j), bb = *((const f32x4*)b1 + lane + 64 * j);
            u32x2 w; w.x = cvt_pk_bf16(v[j].x * rstd * gg.x + bb.x, v[j].y * rstd * gg.y + bb.y); w.y = cvt_pk_bf16(v[j].z * rstd * gg.z + bb.z, v[j].w * rstd * gg.w + bb.w); o8[64 * j] = w; }
    }
    LAS float* scr = (LAS float*)(F.lds + F.wave * 8704);
    bf16* Wgu = (bf16*)(ws_ + WS_X); bf16* Wd = (bf16*)(ws_ + WS_RA);
    const float* wg = KIN(14); const float* wu = KIN(15); const float* wd = KIN(16);
    for (int it = gw; it < NE * 384; it += NGW) {
        const int e = it / 384, r = it % 384;
        if (r < 128) { const int kb = r / 8, nb = r % 8; tr_item(wg + (size_t)e * D * EFF, EFF, 64 * kb, 32 * nb, Wgu + (size_t)e * 512 * D, D, 256 * (nb >> 2) + 32 * (nb & 3), scr, lane); }
        else if (r < 256) { const int q = r - 128, kb = q / 8, nb = q % 8; tr_item(wu + (size_t)e * D * EFF, EFF, 64 * kb, 32 * nb, Wgu + (size_t)e * 512 * D, D, 256 * (nb >> 2) + 128 + 32 * (nb & 3), scr, lane); }
        else { const int q = r - 256, kb = q / 32, nb = q % 32; tr_item(wd + (size_t)e * EFF * D, D, 64 * kb, 32 * nb, Wd + (size_t)e * D * EFF, EFF, 32 * nb, scr, lane); }
    }
}

__device__ __forceinline__ void p8_route(Frame& F) {
    unsigned char* const ws_ = KWS(); float* const out_ = KOUT(); (void)ws_; (void)out_;
    const float* logits = (const float*)(ws_ + WS_LOGITS); const float* brt = KIN(13);
    int* eidx = (int*)(ws_ + TB_EIDX); float* egate = (float*)(ws_ + TB_EGATE); int* wgcnt = (int*)(ws_ + TB_WGCNT);
    LAS int* hist = (LAS int*)(F.lds);
    const int lane = F.lane;
    if (F.tid < 256) hist[F.tid] = 0;
    __syncthreads();
    const f32x4 bias = *((const f32x4*)brt + lane);
    const int wg = F.vcu;
    for (int tt = 0; tt < 32; ++tt) {
        const int t = wg * 256 + F.wave * 32 + tt;
        const f32x4 lg = *((const f32x4*)(logits + (size_t)t * NE) + lane);
        float sc[4], sel[4];
#pragma unroll
        for (int i = 0; i < 4; ++i) { sc[i] = 1.0f / (1.0f + expf(-lg[i])); sel[i] = sc[i] + bias[i]; }
        float m1 = fmaxf(sel[0], sel[1]), m2 = fminf(sel[0], sel[1]);
        { const float n1 = fmaxf(sel[2], sel[3]), n2 = fminf(sel[2], sel[3]); const float hi = fmaxf(m1, n1); m2 = fmaxf(fminf(m1, n1), fmaxf(m2, n2)); m1 = hi; }
#pragma unroll
        for (int off = 1; off < 8; off <<= 1) { const float o1 = __shfl_xor(m1, off), o2 = __shfl_xor(m2, off); const float hi = fmaxf(m1, o1); m2 = fmaxf(fminf(m1, o1), fmaxf(m2, o2)); m1 = hi; }
        const float gs = m1 + m2; const int myg = lane >> 3; int rank = 0;
#pragma unroll
        for (int g = 0; g < 8; ++g) { const float og = __shfl(gs, 8 * g); rank += (og > gs || (og == gs && g < myg)) ? 1 : 0; }
        const bool gsel = rank < 4;
#pragma unroll
        for (int i = 0; i < 4; ++i) sel[i] = gsel ? sel[i] : -__builtin_inff();
        int myidx = 0; float mygate = 0.f; float gsum = 0.f;
#pragma unroll
        for (int k = 0; k < 8; ++k) {
            float bv = sel[0]; int bi = 4 * lane;
#pragma unroll
            for (int i = 1; i < 4; ++i) if (sel[i] > bv) { bv = sel[i]; bi = 4 * lane + i; }
#pragma unroll
            for (int off = 32; off >= 1; off >>= 1) { const float ov = __shfl_xor(bv, off); const int oi = __shfl_xor(bi, off); if (ov > bv || (ov == bv && oi < bi)) { bv = ov; bi = oi; } }
            const int sub = bi & 3; const float cand = sub == 0 ? sc[0] : (sub == 1 ? sc[1] : (sub == 2 ? sc[2] : sc[3]));
            const float gk = __shfl(cand, bi >> 2);
            if (lane == (bi >> 2)) {
#pragma unroll
                for (int i = 0; i < 4; ++i) if (i == sub) sel[i] = -__builtin_inff(); }
            gsum += gk;
            if (lane == k) { myidx = bi; mygate = gk; }
        }
        if (lane < 8) { eidx[(size_t)t * 8 + lane] = myidx; egate[(size_t)t * 8 + lane] = mygate / gsum * 2.5f; __hip_atomic_fetch_add(&hist[myidx], 1, __ATOMIC_RELAXED, __HIP_MEMORY_SCOPE_WORKGROUP); }
    }
    __syncthreads();
    if (F.tid < 256) wgcnt[wg * 256 + F.tid] = hist[F.tid];
}

__device__ __forceinline__ int excl_scan512(int v, LAS int* tmp, int tid, int& total) {
    const int lane = tid & 63, wid = tid >> 6; int x = v;
#pragma unroll
    for (int o = 1; o < 64; o <<= 1) { const int y = __shfl_up(x, o); if (lane >= o) x += y; }
    __syncthreads();
    if (lane == 63) tmp[wid] = x;
    __syncthreads();
    int base = 0, tot = 0;
#pragma unroll
    for (int w = 0; w < 8; ++w) { const int tv = tmp[w]; tot += tv; if (w < wid) base += tv; }
    total = tot;
    return base + x - v;
}
__device__ __forceinline__ void p9_dispatch(Frame& F) {
    unsigned char* const ws_ = KWS(); float* const out_ = KOUT(); (void)ws_; (void)out_;
    const int* wgcnt = (const int*)(ws_ + TB_WGCNT); const int* eidx = (const int*)(ws_ + TB_EIDX); const float* egate = (const float*)(ws_ + TB_EGATE);
    int* yrow = (int*)(ws_ + TB_YROW); unsigned* stok = (unsigned*)(ws_ + TB_STOK); float* sgate = (float*)(ws_ + TB_SGATE); int* gtab = (int*)(ws_ + TB_GTAB);
    LAS int* L = (LAS int*)(F.lds);
    LAS int* s_base = L, *s_tot0 = L + 260, *s_yb0 = L + 520, *s_yb1 = L + 780, *s_my = L + 1040, *s_cnt = L + 1300, *tmp = L + 1560;
    const int tid = F.tid, wg = F.vcu, e = tid;
    int t0 = 0, t1 = 0, my = 0;
    if (tid < 256) {
        for (int w = 0; w < 256; ++w) { const int c = wgcnt[w * 256 + e]; if (w < 128) t0 += c; else t1 += c; if (w < wg) my += c; }
        s_cnt[e] = 0; s_my[e] = my; s_tot0[e] = t0;
    }
    const int n = t0 + t1;
    int tot;
    const int base = excl_scan512(tid < 256 ? n : 0, tmp, tid, tot);
    const int yb0 = excl_scan512(tid < 256 ? t0 : 0, tmp, tid, tot);
    const int yb1 = excl_scan512(tid < 256 ? t1 : 0, tmp, tid, tot);
    int nt1, nt20, nt21;
    const int ts1 = excl_scan512(tid < 256 ? (n + 255) / 256 : 0, tmp, tid, nt1);
    const int ts20 = excl_scan512(tid < 256 ? (t0 + 255) / 256 : 0, tmp, tid, nt20);
    const int ts21 = excl_scan512(tid < 256 ? (t1 + 255) / 256 : 0, tmp, tid, nt21);
    if (tid < 256) { s_base[e] = base; s_yb0[e] = yb0; s_yb1[e] = yb1; }
    if (wg == 0) {
        if (tid < 256) { gtab[GT_BASE * 260 + e] = base; gtab[GT_N * 260 + e] = n; gtab[GT_TOT0 * 260 + e] = t0; gtab[GT_YB0 * 260 + e] = yb0; gtab[GT_YB1 * 260 + e] = yb1;
            gtab[GT_TS1 * 260 + e] = ts1; gtab[GT_TS20 * 260 + e] = ts20; gtab[GT_TS21 * 260 + e] = ts21; }
        if (tid == 0) { gtab[GT_TS1 * 260 + 256] = nt1; gtab[GT_TS20 * 260 + 256] = nt20; gtab[GT_TS21 * 260 + 256] = nt21; }
    }
    __syncthreads();
    const int half = wg >= 128 ? 1 : 0;
    {
        const int t = wg * 256 + (tid >> 1), k0 = (tid & 1) * 4;
#pragma unroll
        for (int kk = 0; kk < 4; ++kk) { const int k = k0 + kk; const int ee = eidx[(size_t)t * 8 + k]; const float gt = egate[(size_t)t * 8 + k];
            const int r = __hip_atomic_fetch_add(&s_cnt[ee], 1, __ATOMIC_RELAXED, __HIP_MEMORY_SCOPE_WORKGROUP);
            const int within = s_my[ee] + r;
            const int slot = s_base[ee] + within;
            stok[slot] = (unsigned)t * 4096u; sgate[slot] = gt;
            yrow[(size_t)t * 8 + k] = (half ? s_yb1[ee] : s_yb0[ee]) + within - (half ? s_tot0[ee] : 0);
        }
    }
    if (tid < 256) { const int t = wg * 256 + tid; stok[NSR + t] = (unsigned)t * 4096u; sgate[NSR + t] = 1.0f; }
    if (wg == 0 && tid < 256) { stok[NSLOT + tid] = 0u; sgate[NSLOT + tid] = 0.f; }
}

__device__ __forceinline__ int find_expert(const LAS int* ts, int tile) {
    int lo = 0, hi = 256;
#pragma unroll 1
    while (hi - lo > 1) { const int mid = (lo + hi) >> 1; if (ts[mid] <= tile) lo = mid; else hi = mid; }
    return lo;
}
struct Gemm1Sched {
    const LAS int* ts; const LAS int* base; const LAS int* nn; const LAS unsigned* tab; int NT1, G, c;
    const char* h1; const char* Wgu; const char* Wsgu; char* Hbuf;
    __device__ __forceinline__ bool next(int i, g8::UnitG& u) const {
        const int L = i * G + c; const int tile = L >> 1, pn = L & 1;
        if (tile >= NT1 + T / 256) return false;
        int e, r, slot0, valid; const char* B;
        if (tile < NT1) { e = find_expert(ts, tile); r = tile - ts[e]; slot0 = base[e] + 256 * r; valid = nn[e] - 256 * r; valid = valid > 256 ? 256 : valid; B = Wgu + ((size_t)(e * 2 + pn) * 256) * D * 2; }
        else { r = tile - NT1; slot0 = NSR + 256 * r; valid = 256; B = Wsgu + ((size_t)pn * 256) * D * 2; }
        u.A = h1; u.B = B; u.O = Hbuf + (size_t)slot0 * (EFF * 2) + pn * 256; u.ldo = EFF * 2; u.p0 = slot0; u.p1 = valid; u.p2 = pn; return true;
    }
    static constexpr bool GATHER = true;
    __device__ __forceinline__ int pitch() const { return 0; }
    __device__ __forceinline__ unsigned aoff(int ui, int row, int cb) const { return tab[ui * 256 + row] + (unsigned)cb; }
};
struct Gemm2Sched {
    const LAS int* ts; const LAS int* base; const LAS int* cntv; const LAS int* yb; const LAS int* tot0; int NT2, G, c, half;
    const char* Hbuf; const char* Wd; const char* Wsd; char* Y; char* out;
    __device__ __forceinline__ bool next(int i, g8::UnitG& u) const {
        const int L = i * G + c; const int tile = L >> 2, pn = L & 3;
        if (tile >= NT2 + HALF_T / 256) return false;
        if (tile < NT2) { const int e = find_expert(ts, tile), r = tile - ts[e]; const int slot0 = base[e] + (half ? tot0[e] : 0) + 256 * r; int valid = cntv[e] - 256 * r; valid = valid > 256 ? 256 : valid;
            u.A = Hbuf + (size_t)slot0 * (EFF * 2); u.B = Wd + ((size_t)e * D + 256 * pn) * EFF * 2; u.O = Y + (size_t)(yb[e] + 256 * r) * 2048 + pn * 512; u.ldo = 2048; u.p0 = slot0; u.p1 = valid; u.p2 = 0; }
        else { const int r = tile - NT2; const int tok0 = half * HALF_T + 256 * r; const int slot0 = NSR + tok0;
            u.A = Hbuf + (size_t)slot0 * (EFF * 2); u.B = Wsd + ((size_t)256 * pn) * EFF * 2; u.O = out + (size_t)tok0 * 4096 + 2048 + pn * 512; u.ldo = 4096; u.p0 = slot0; u.p1 = 256; u.p2 = 1; }
        return true;
    }
    static constexpr bool GATHER = false;
    __device__ __forceinline__ int pitch() const { return EFF * 2; }
    __device__ __forceinline__ unsigned aoff(int, int row, int cb) const { return (unsigned)(row * EFF * 2 + cb); }
};

__device__ __forceinline__ void p_combine(Frame& F, int half) {
    unsigned char* const ws_ = KWS(); float* const out_ = KOUT();
    const float* g2 = KIN(20); const float* b2 = KIN(21);
    const int* yrow = (const int*)(ws_ + TB_YROW); const char* Y = (const char*)(ws_ + WS_X);
    const int gw = F.vcu * NWAVES + F.wave, NGW = F.G * NWAVES, lane = F.lane;
    for (int tt = gw; tt < HALF_T; tt += NGW) {
        const int t = half * HALF_T + tt;
        char* orow = (char*)out_ + (size_t)t * 4096;
        float acc[16];
        { float t8[8]; unpack8(*(const u32x4*)(orow + 32 * lane), t8);
#pragma unroll
          for (int j = 0; j < 8; ++j) acc[j] = ALPHA * t8[j];
          unpack8(*(const u32x4*)(orow + 32 * lane + 16), t8);
#pragma unroll
          for (int j = 0; j < 8; ++j) acc[8 + j] = ALPHA * t8[j]; }
        if ((DBG_STAGE == 0)) { float t8[8]; unpack8(*(const u32x4*)(orow + 2048 + 32 * lane), t8);
#pragma unroll
          for (int j = 0; j < 8; ++j) acc[j] += t8[j];
          unpack8(*(const u32x4*)(orow + 2048 + 32 * lane + 16), t8);
#pragma unroll
          for (int j = 0; j < 8; ++j) acc[8 + j] += t8[j]; }
        const int myrow = ((DBG_STAGE == 0)) ? yrow[(size_t)t * 8 + (lane & 7)] : 0;
#pragma unroll
        for (int k = 0; k < (((DBG_STAGE == 0)) ? 8 : 0); ++k) { const int yr = __shfl(myrow, k); const char* yp = Y + (size_t)yr * 2048 + 32 * lane; float t8[8];
            unpack8(*(const u32x4*)(yp), t8);
#pragma unroll
            for (int j = 0; j < 8; ++j) acc[j] += t8[j];
            unpack8(*(const u32x4*)(yp + 16), t8);
#pragma unroll
            for (int j = 0; j < 8; ++j) acc[8 + j] += t8[j]; }
        float s = 0.f;
#pragma unroll
        for (int j = 0; j < 16; ++j) s += acc[j];
        const float mean = wave_sum(s) * (1.f / D); float s2 = 0.f;
#pragma unroll
        for (int j = 0; j < 16; ++j) { acc[j] -= mean; s2 += acc[j] * acc[j]; }
        const float rstd = 1.f / sqrtf(wave_sum(s2) * (1.f / D) + EPS);
#pragma unroll
        for (int q = 0; q < 4; ++q) { const f32x4 gg = *((const f32x4*)(g2 + 16 * lane) + q), bb = *((const f32x4*)(b2 + 16 * lane) + q);
            *((f32x4*)(orow + 64 * lane) + q) = (f32x4){acc[4 * q] * rstd * gg.x + bb.x, acc[4 * q + 1] * rstd * gg.y + bb.y, acc[4 * q + 2] * rstd * gg.z + bb.z, acc[4 * q + 3] * rstd * gg.w + bb.w}; }
    }
}

__device__ __forceinline__ void load_gtabs(Frame& F, LAS int* dst) {
    unsigned char* const ws_ = KWS();
    const int* gtab = (const int*)(ws_ + TB_GTAB);
    for (int i = F.tid; i < 8 * 260; i += NTHREADS) dst[i] = gtab[i];
    __syncthreads();
}

__global__ void __launch_bounds__(NTHREADS, 2) hymba_fwd(Args args) {
    extern __shared__ __attribute__((aligned(16))) unsigned char lds_raw[];
#define MKFRAME() Frame F; { F.lds = (LAS unsigned char*)lds_raw; int t_ = threadIdx.x; asm volatile("" : "+v"(t_)); F.tid = t_; F.lane = t_ & 63; F.wave = __builtin_amdgcn_readfirstlane(t_ >> 6); \
        F.G = gridDim.x; const int bx = blockIdx.x; F.vcu = (F.G % 8 == 0) ? (bx % 8) * (F.G / 8) + bx / 8 : bx; }
    volatile LAS unsigned* MISC = (volatile LAS unsigned*)((LAS unsigned char*)lds_raw + LDS_MISC);
    if (threadIdx.x < 32) MISC[threadIdx.x] = 0u;
    __syncthreads();
    unsigned* ctl = (unsigned*)(KWS() + WS_CTL);
    XcdBarrier bar; bar.bar = ctl + CW_BAR; bar.x = 0; bar.st = nullptr;
    if (MK_LAUNCHES == 1) bar = xcd_barrier_post(ctl + CW_BAR, MISC + 8);
    const int lo = karg32<192>(), hi = karg32<196>();
#ifndef PH_MASK
#define PH_MASK 0x7fff
#endif
#define IN(k) ((((PH_MASK) >> (k)) & 1) && lo <= (k) && (k) < hi)
#define SEAM(k) do { if (IN(k) && IN((k) + 1)) xcd_barrier(bar); } while (0)

    if (IN(0)) { MKFRAME(); p0_prologue(F); } SEAM(0);
    if (IN(1)) {
        MKFRAME(); unsigned char* const ws_ = KWS();
        g8::DenseSched S; S.init(ws_ + WS_RA, ws_ + W_WINT, ws_ + WS_RB, T, NPJ, D, NPJ * 2, 2, F.G, (int)blockIdx.x);
        g8::EpiBf16 E; g8::gemm_core<g8::EpiBf16, g8::DenseSched>(F.lds + LDS_STAGE, D, S, E);
    } SEAM(1);
    if (IN(2)) { MKFRAME(); p2_prep(F); } SEAM(2);
#if GDN_RECURRENT
    if (IN(3)) { MKFRAME(); p3_gdn_recurrent(F); } SEAM(3);
    if (IN(4)) { MKFRAME(); p4_gdn_gate(F); } SEAM(4);
#else
    if (IN(3)) { MKFRAME(); p3_gdn_local(F); } SEAM(3);
    if (IN(4)) { MKFRAME(); p4_gdn_scan(F); } SEAM(4);
#endif
    if (IN(5)) {
        MKFRAME(); unsigned char* const ws_ = KWS();
        g8::DenseSched S; S.init(ws_ + WS_RA, ws_ + W_WOUTT, ws_ + WS_MIX, T, D, D, D * 2, 2, F.G, (int)blockIdx.x);
        g8::EpiBf16 E; g8::gemm_core<g8::EpiBf16, g8::DenseSched>(F.lds + LDS_STAGE, D, S, E);
    } SEAM(5);
    if (IN(6)) { MKFRAME(); p6_ln1_and_wexp(F); } SEAM(6);
    if (IN(7)) {
        MKFRAME(); unsigned char* const ws_ = KWS(); float* const out_ = KOUT();
        struct RSched : g8::DenseSched {
            __device__ __forceinline__ bool next(int i, g8::UnitG& u) const { if (!g8::DenseSched::next(i, u)) return false; u.A = A + (size_t)u.p0 * 256 * 4096; return true; }
            __device__ __forceinline__ int pitch() const { return 4096; }
            __device__ __forceinline__ unsigned aoff(int, int row, int cb) const { return (unsigned)(row * 4096 + cb); }
        } S; S.init(out_, ws_ + W_WRT, ws_ + WS_LOGITS, T, NE, D, NE * 4, 4, F.G, (int)blockIdx.x);
        g8::EpiF32 E; g8::gemm_core<g8::EpiF32, RSched>(F.lds + LDS_STAGE, D, S, E);
    } SEAM(7);
    if (IN(8)) { MKFRAME(); p8_route(F); } SEAM(8);
    if (IN(9)) { MKFRAME(); p9_dispatch(F); } SEAM(9);
    if (IN(10)) {
        MKFRAME(); unsigned char* const ws_ = KWS(); float* const out_ = KOUT();
        LAS int* tb = (LAS int*)(F.lds + LDS_TS); load_gtabs(F, tb);
        Gemm1Sched S; S.ts = tb + GT_TS1 * 260; S.base = tb + GT_BASE * 260; S.nn = tb + GT_N * 260; S.tab = (const LAS unsigned*)(F.lds + LDS_AUX); S.NT1 = tb[GT_TS1 * 260 + 256]; S.G = F.G; S.c = F.vcu;
        S.h1 = (const char*)out_; S.Wgu = (const char*)(ws_ + WS_X); S.Wsgu = (const char*)(ws_ + W_WSGU); S.Hbuf = (char*)(ws_ + WS_HBUF);
        {
            const unsigned* stok = (const unsigned*)(ws_ + TB_STOK); LAS unsigned* tab = (LAS unsigned*)(F.lds + LDS_AUX);
            for (int ui = 0; ui < 20; ++ui) { g8::UnitG u; if (!S.next(ui, u)) break;
                if (F.tid < 256) tab[ui * 256 + F.tid] = stok[u.p0 + (F.tid < u.p1 ? F.tid : 0)]; }
            __syncthreads();
        }
        g8::EpiH E; g8::gemm_core<g8::EpiH, Gemm1Sched>(F.lds + LDS_STAGE, D, S, E);
    } SEAM(10);
#define MOE_HALF(PH, HALFV) \
    if (IN(PH)) { \
        MKFRAME(); unsigned char* const ws_ = KWS(); float* const out_ = KOUT(); \
        LAS int* tb = (LAS int*)(F.lds + LDS_TS); load_gtabs(F, tb); \
        LAS int* cv = tb + 8 * 260; \
        if (F.tid < 256) cv[F.tid] = (HALFV) ? (tb[GT_N * 260 + F.tid] - tb[GT_TOT0 * 260 + F.tid]) : tb[GT_TOT0 * 260 + F.tid]; \
        __syncthreads(); \
        Gemm2Sched S; S.ts = tb + ((HALFV) ? GT_TS21 : GT_TS20) * 260; S.base = tb + GT_BASE * 260; S.cntv = cv; S.yb = tb + ((HALFV) ? GT_YB1 : GT_YB0) * 260; S.tot0 = tb + GT_TOT0 * 260; \
        S.NT2 = tb[((HALFV) ? GT_TS21 : GT_TS20) * 260 + 256]; S.G = F.G; S.c = F.vcu; S.half = (HALFV); \
        S.Hbuf = (const char*)(ws_ + WS_HBUF); S.Wd = (const char*)(ws_ + WS_RA); S.Wsd = (const char*)(ws_ + W_WSD); S.Y = (char*)(ws_ + WS_X); S.out = (char*)out_; \
        g8::EpiY E; E.sgate = (const float*)(ws_ + TB_SGATE); \
        g8::gemm_core<g8::EpiY, Gemm2Sched>(F.lds + LDS_STAGE, EFF, S, E); \
    } SEAM(PH); \
    if (IN((PH) + 1)) { MKFRAME(); p_combine(F, (HALFV)); } SEAM((PH) + 1);
    MOE_HALF(11, 0)
    MOE_HALF(13, 1)
#undef IN
#undef SEAM
}

extern "C" void kernel_launch(void* const* d_in, const int* in_sizes, int n_in, void* d_out, int out_size, void* d_ws, size_t ws_size, hipStream_t stream) {
    static int grid = 0;
    if (grid == 0) {
        if (n_in != 22 || out_size != T * D || ws_size < WS_END) { fprintf(stderr, "kernel_launch: unexpected shapes (n_in %d out %d ws %zu need %zu)\n", n_in, out_size, ws_size, (size_t)WS_END); grid = -1; return; }
        int dev = 0, cus = 0, per_cu = 0;
        if (hipGetDevice(&dev) != hipSuccess || hipDeviceGetAttribute(&cus, hipDeviceAttributeMultiprocessorCount, dev) != hipSuccess) { grid = -1; return; }
        if (hipFuncSetAttribute((const void*)hymba_fwd, hipFuncAttributeMaxDynamicSharedMemorySize, LDS_BYTES) != hipSuccess) { fprintf(stderr, "kernel_launch: hipFuncSetAttribute failed\n"); grid = -1; return; }
        if (hipOccupancyMaxActiveBlocksPerMultiprocessor(&per_cu, (const void*)hymba_fwd, NTHREADS, LDS_BYTES) != hipSuccess || per_cu < 1) fprintf(stderr, "kernel_launch: occupancy query says %d\n", per_cu);
        (void)hipGetLastError();
        grid = cus;
        if (grid != 256) fprintf(stderr, "kernel_launch: %d CUs (built for 256)\n", grid);
    }
    if (grid < 0) return;
    (void)hipMemsetAsync((char*)d_ws + WS_CTL, 0, CTL_BYTES, stream);
    Args a{};
    for (int i = 0; i < 22; ++i) a.in[i] = (const float*)d_in[i];
    a.out = (float*)d_out; a.ws = (unsigned char*)d_ws; a.li = 0; a.pad = 0;
#if MK_LAUNCHES == 1
    a.ph_lo = 0; a.ph_hi = NPHASE;
    hipLaunchKernelGGL(hymba_fwd, dim3(grid), dim3(NTHREADS), LDS_BYTES, stream, a);
#else
    for (int p = 0; p < NPHASE; ++p) { if ((DBG_STAGE == 1 || DBG_STAGE == 5) && p >= 7 && p != 12 && p != 14) continue; if (DBG_STAGE == 3 && p != 6 && p != 12 && p != 14) continue; if (DBG_STAGE == 4 && p != 0 && p != 1 && p != 2 && p != 5 && p != 6 && p != 12 && p != 14) continue; a.ph_lo = p; a.ph_hi = p + 1; a.li = p; hipLaunchKernelGGL(hymba_fwd, dim3(grid), dim3(NTHREADS), LDS_BYTES, stream, a); }
#endif
}
```

```cpp
#include <hip/hip_runtime.h>
#include <cstdio>
#include <cstdint>

#ifndef DBG_STAGE
#define DBG_STAGE 0
#endif
#ifndef GDN_PROBE
#define GDN_PROBE 0
#endif
constexpr int CW_DBG = 64;
#ifndef MK_LAUNCHES
#define MK_LAUNCHES 1
#endif

#define LAS __attribute__((address_space(3)))
#define GAS __attribute__((address_space(1)))
typedef unsigned short bf16;
typedef short bf16x8 __attribute__((ext_vector_type(8)));
typedef float f32x4 __attribute__((ext_vector_type(4)));
typedef float f32x2 __attribute__((ext_vector_type(2)));
typedef unsigned u32x4 __attribute__((ext_vector_type(4)));
typedef unsigned u32x2 __attribute__((ext_vector_type(2)));

constexpr int BATCH = 32, SEQ = 2048, D = 1024, T = BATCH * SEQ;
constexpr int NMETA = 16, CW = 512, GWID = 512, NHEAD = 4, HD = 128, INC = 3592, NPJ = 3584;
constexpr int NE = 256, TOPK = 8, EFF = 256;
constexpr float ALPHA = 1.189207115002721f, EPS = 1e-5f;
constexpr int NPHASE = 15;
constexpr int NTHREADS = 512, NWAVES = 8;
constexpr int NSR = T * TOPK;
constexpr int NSLOT = NSR + T;
constexpr int HALF_T = T / 2;

constexpr size_t MiB = 1u << 20;
constexpr size_t WS_CTL = 0, CTL_BYTES = 1 * MiB;
constexpr size_t WS_TAB = 1 * MiB;
constexpr size_t TB_WGCNT = WS_TAB;
constexpr size_t TB_GTAB = TB_WGCNT + 256 * 256 * 4;
constexpr size_t TB_EIDX = TB_GTAB + 16 * 260 * 4 + 1536;
constexpr size_t TB_EGATE = TB_EIDX + (size_t)T * 8 * 4;
constexpr size_t TB_YROW = TB_EGATE + (size_t)T * 8 * 4;
constexpr size_t TB_STOK = TB_YROW + (size_t)T * 8 * 4;
constexpr size_t TB_SGATE = TB_STOK + (size_t)(NSLOT + 256) * 4;
constexpr size_t TB_BD = TB_SGATE + (size_t)(NSLOT + 256) * 4;
constexpr size_t TB_BETA = TB_BD + (size_t)T * 8 * 4;
constexpr size_t TB_G = TB_BETA + (size_t)T * 4 * 4;
constexpr size_t TB_PROJM = TB_G + (size_t)T * 4 * 4;
constexpr size_t TB_METAQ = TB_PROJM + 16 * INC * 4;
constexpr size_t TB_METAK = TB_METAQ + 64 * 512 * 2;
constexpr size_t TB_METAV = TB_METAK + 64 * 512 * 2;
constexpr size_t TB_METAB = TB_METAV + 64 * 512 * 2;
constexpr size_t TB_METAG = TB_METAB + 64 * 4 * 4;
constexpr size_t TB_END = TB_METAG + 64 * 4 * 4;
constexpr size_t WS_WSM = 17 * MiB;
constexpr size_t W_WINT = WS_WSM;
constexpr size_t W_WOUTT = W_WINT + (size_t)NPJ * D * 2;
constexpr size_t W_WRT = W_WOUTT + (size_t)D * D * 2;
constexpr size_t W_WSGU = W_WRT + (size_t)NE * D * 2;
constexpr size_t W_WSD = W_WSGU + (size_t)512 * D * 2;
constexpr size_t W_END = W_WSD + (size_t)D * EFF * 2;
constexpr size_t WS_RA = 29 * MiB;
constexpr size_t WS_RB = 157 * MiB;
constexpr size_t WS_HBUF = 157 * MiB;
constexpr size_t WS_X = 446 * MiB;
constexpr size_t WS_QN = 605 * MiB, WS_KN = 669 * MiB, WS_VV = 733 * MiB;
constexpr size_t WS_ZB = 797 * MiB;
constexpr size_t WS_MIX = 733 * MiB;
constexpr size_t WS_LOGITS = 861 * MiB;
constexpr size_t WS_END = 958 * MiB;
constexpr int GBLK = 81920;
constexpr int GB_UT = 0, GB_WP = 18432, GB_QD = 35840, GB_KDT = 53248, GB_ATT = 71680, GB_EG = 80896;
static_assert(TB_END <= WS_WSM && W_END <= WS_RA, "ws map");
static_assert(WS_RB + (size_t)T * NPJ * 2 <= WS_QN && WS_RB + (size_t)4100 * GBLK <= WS_QN, "ws map");
static_assert(WS_HBUF + (size_t)(NSLOT + 256) * 512 <= WS_X && WS_X + (size_t)(NE * 512) * D * 2 <= WS_MIX, "ws map");
static_assert(WS_X + (size_t)(HALF_T * 8) * 2048 <= WS_END, "ws map");

constexpr int CW_BAR = 4096;

constexpr int LDS_STAGE = 0;
constexpr int LDS_AUX = 131072;
constexpr int LDS_TS = LDS_AUX + 20480;
constexpr int LDS_MISC = LDS_TS + 9344;
constexpr int LDS_BYTES = LDS_MISC + 128;
static_assert(LDS_BYTES <= 163840, "LDS");

typedef __bf16 bf16x2_t __attribute__((ext_vector_type(2)));
__device__ __forceinline__ unsigned cvt_pk_bf16(float lo, float hi) { const f32x2 v = {lo, hi}; return __builtin_bit_cast(unsigned, __builtin_convertvector(v, bf16x2_t)); }
__device__ __forceinline__ float bf_lo(unsigned w) { return __uint_as_float(w << 16); }
__device__ __forceinline__ float bf_hi(unsigned w) { return __uint_as_float(w & 0xffff0000u); }
__device__ __forceinline__ float bf2f(bf16 b) { return __uint_as_float(((unsigned)b) << 16); }
__device__ __forceinline__ void unpack8(const u32x4 w, float (&o)[8]) { o[0] = bf_lo(w.x); o[1] = bf_hi(w.x); o[2] = bf_lo(w.y); o[3] = bf_hi(w.y); o[4] = bf_lo(w.z); o[5] = bf_hi(w.z); o[6] = bf_lo(w.w); o[7] = bf_hi(w.w); }
__device__ __forceinline__ u32x4 pack8(const float (&v)[8]) { u32x4 w; w.x = cvt_pk_bf16(v[0], v[1]); w.y = cvt_pk_bf16(v[2], v[3]); w.z = cvt_pk_bf16(v[4], v[5]); w.w = cvt_pk_bf16(v[6], v[7]); return w; }
__device__ __forceinline__ float wave_sum(float v) {
#pragma unroll
    for (int o = 1; o < 64; o <<= 1) v += __shfl_xor(v, o);
    return v;
}
__device__ __forceinline__ float fast_exp(float x) { return __builtin_amdgcn_exp2f(x * 1.4426950408889634f); }
__device__ __forceinline__ float sigmoidf_(float x) { return __builtin_amdgcn_rcpf(1.0f + fast_exp(-x)); }
__device__ __forceinline__ float siluf_(float x) { return x * sigmoidf_(x); }
#define LDS_WAIT() asm volatile("s_waitcnt lgkmcnt(0)" ::: "memory")
#define VM_WAIT() asm volatile("s_waitcnt vmcnt(0)" ::: "memory")

#define XB_TMO      128
#define XB_XCNT(j)  (256  + 64 * (j))
#define XB_XSUB(j)  (1280 + 64 * (j))
#define XB_XGEN(j)  (2304 + 64 * (j))
#define XB_TOP      3328
#define XB_TOPGEN   3392
#define XCD_BAR_WORDS 3456
#define XB_SPIN_CAP (1u << 22)
__device__ __forceinline__ unsigned xb_ld(unsigned* p)              { return __hip_atomic_load(p, __ATOMIC_RELAXED, __HIP_MEMORY_SCOPE_AGENT); }
__device__ __forceinline__ unsigned xb_add(unsigned* p, unsigned v) { return __hip_atomic_fetch_add(p, v, __ATOMIC_RELAXED, __HIP_MEMORY_SCOPE_AGENT); }
__device__ __forceinline__ unsigned xb_xcc_id() { return (unsigned)__builtin_amdgcn_s_getreg((3 << 11) | 20) & 0xFu; }
#define XB_SPIN(cond, bar) do { unsigned _sp = 0; while (cond) { __builtin_amdgcn_s_sleep(1); \
    if ((++_sp & 255u) == 0u) { if (xb_ld(&(bar)[XB_TMO])) break; if (_sp > XB_SPIN_CAP) { atomicAdd(&(bar)[XB_TMO], 1u); break; } } } } while (0)
struct XcdBarrier { unsigned* bar; unsigned x; volatile LAS unsigned* st; };
__device__ __forceinline__ XcdBarrier xcd_barrier_post(unsigned* bar, volatile LAS unsigned* st) {
    XcdBarrier b; b.bar = bar; b.x = xb_xcc_id(); b.st = st;
    if (threadIdx.x == 0) (void)xb_add(&bar[XB_XCNT(b.x)], 1u);
    return b;
}
__device__ __forceinline__ void xcd_barrier_complete(unsigned* bar, unsigned x, unsigned& nloc, unsigned& nx) {
    const unsigned G = gridDim.x * gridDim.y * gridDim.z;
    unsigned sum, cnt, mine, sp = 0u;
    for (;;) {
        sum = 0u; cnt = 0u; mine = 0u;
#pragma unroll
        for (unsigned j = 0; j < 16; ++j) { const unsigned c = xb_ld(&bar[XB_XCNT(j)]); sum += c; cnt += (c > 0u) ? 1u : 0u; mine = (j == x) ? c : mine; }
        if (sum == G) break;
        __builtin_amdgcn_s_sleep(1);
        if ((++sp & 255u) == 0u) { if (xb_ld(&bar[XB_TMO])) break; if (sp > XB_SPIN_CAP) { atomicAdd(&bar[XB_TMO], 1u); break; } }
    }
    nloc = mine > 0u ? mine : 1u; nx = cnt > 0u ? cnt : 1u;
}
__device__ __forceinline__ void xcd_barrier(const XcdBarrier& b) {
    asm volatile("s_waitcnt vmcnt(0)" ::: "memory");
    __syncthreads();
    if (threadIdx.x == 0) {
        unsigned* bar = b.bar;
        __builtin_amdgcn_s_waitcnt(0);
        unsigned nloc = b.st[0], nx = b.st[1];
        if (nloc == 0u) { xcd_barrier_complete(bar, b.x, nloc, nx); b.st[0] = nloc; b.st[1] = nx; }
        const unsigned old = xb_add(&bar[XB_XSUB(b.x)], 1u);
        const unsigned gen = old / nloc;
        if (old + 1u == (gen + 1u) * nloc) {
            __builtin_amdgcn_fence(__ATOMIC_RELEASE, "agent");
            asm volatile("s_waitcnt vmcnt(0)" ::: "memory");
            const unsigned og = xb_add(&bar[XB_TOP], 1u);
            const unsigned tg = og / nx;
            if (og + 1u == (tg + 1u) * nx) xb_add(&bar[XB_TOPGEN], 1u);
            else XB_SPIN(xb_ld(&bar[XB_TOPGEN]) == tg, bar);
            __builtin_amdgcn_fence(__ATOMIC_ACQUIRE, "agent");
            xb_add(&bar[XB_XGEN(b.x)], 1u);
            asm volatile("s_waitcnt vmcnt(0)" ::: "memory");
        } else {
            XB_SPIN(xb_ld(&bar[XB_XGEN(b.x)]) == gen, bar);
            __builtin_amdgcn_fence(__ATOMIC_ACQUIRE, "agent");
            asm volatile("s_waitcnt vmcnt(0)" ::: "memory");
        }
    }
    __syncthreads();
}

namespace g8 {
constexpr int BM = 256, BK = 64, HALF = 128, HTB = HALF * BK * 2, STAGE_BYTES = 8 * HTB, NXCD = 8, WGM = 8;
__host__ __device__ __forceinline__ int lds_byte(int r, int c) { const int st = (r >> 4) * 2 + (c >> 5), rr = r & 15, cc = c & 31, ob = rr * 64 + cc * 2; return st * 1024 + (ob ^ (((ob >> 9) & 1) << 5)); }
__host__ __device__ __forceinline__ void stage_rc(int b, int& R, int& C) { const int st = b / 1024, sb = b % 1024, swz = sb ^ (((sb >> 9) & 1) << 5); R = (st >> 1) * 16 + swz / 64; C = (st & 1) * 32 + (swz % 64) / 2; }
__host__ __device__ __forceinline__ int perm32(int rho) { const int n = rho >> 4, i = rho & 15; return 8 * (i >> 2) + 4 * n + (i & 3); }

struct UnitG { const char* A; const char* B; char* O; int ldo; int p0, p1, p2; };

template <class Epi, class Sched>
__device__ __forceinline__ void gemm_core(LAS unsigned char* lds, const int K, const Sched& S, const Epi& E) {
    int tid = threadIdx.x; asm volatile("" : "+v"(tid));
    const int wid = __builtin_amdgcn_readfirstlane(tid >> 6), lane = tid & 63, wr = wid >> 2, wc = wid & 3, fr = lane & 15, fq = lane >> 4;
    const int nt = K / BK;
    int R0, C0; stage_rc(tid * 16, R0, C0);
    unsigned voffB[2];
#pragma unroll
    for (int i = 0; i < 2; ++i) { const int R = R0 + 64 * i; const int Rb = Epi::PERM ? ((R & ~31) + perm32(R & 31)) : R; voffB[i] = (unsigned)(Rb * K + C0) * 2u; }
    const size_t kstep = (size_t)(BK * 2);
    const size_t hstep = (size_t)HALF * K * 2;
    const unsigned ldsw = (unsigned)wid * 1024u;
    const int aoff = lds_byte(wr * 64 + fr, fq * 8), boff = lds_byte(wc * 32 + fr, fq * 8);
#define G8_SA(b, h) (((b) * 2 + (h)) * HTB)
#define G8_SB(b, h) ((4 + (b) * 2 + (h)) * HTB)
#define G8_STAGE(bufoff, gbase, voff) do { _Pragma("unroll") for (int _i = 0; _i < 2; ++_i) \
        __builtin_amdgcn_global_load_lds((const unsigned*)((const char*)(gbase) + (voff)[_i]), (LAS unsigned*)(lds + (bufoff) + ldsw + _i * 8192), 16, 0, 0); } while (0)
#define G8_STAGE_A(bufoff, gbase, h) do { if constexpr (Sched::GATHER) { G8_STAGE(bufoff, gbase, ao[h]); } else { G8_STAGE(bufoff, (gbase) + (h) * hstepA, ao[0]); } } while (0)
#define G8_LDA(dst, b, h) do { _Pragma("unroll") for (int m = 0; m < 4; ++m) _Pragma("unroll") for (int k = 0; k < 2; ++k) dst[m][k] = *(const LAS bf16x8*)(lds + G8_SA(b, h) + aoff + m * 2048 + k * 1024); } while (0)
#define G8_LDB(dst, b, h) do { _Pragma("unroll") for (int n = 0; n < 2; ++n) _Pragma("unroll") for (int k = 0; k < 2; ++k) dst[n][k] = *(const LAS bf16x8*)(lds + G8_SB(b, h) + boff + n * 2048 + k * 1024); } while (0)
#define G8_MMA(ai, bj, At, Bt) do { __builtin_amdgcn_s_setprio(1); _Pragma("unroll") for (int m = 0; m < 4; ++m) _Pragma("unroll") for (int n = 0; n < 2; ++n) _Pragma("unroll") for (int k = 0; k < 2; ++k) \
        acc[ai][bj][m][n] = __builtin_amdgcn_mfma_f32_16x16x32_bf16(Bt[n][k], At[m][k], acc[ai][bj][m][n], 0, 0, 0); __builtin_amdgcn_s_setprio(0); } while (0)
#define G8_WAIT_V(n) asm volatile("s_waitcnt vmcnt(" #n ")" ::: "memory")
#define G8_WAIT_L(n) asm volatile("s_waitcnt lgkmcnt(" #n ")" ::: "memory")
#define G8_BAR __builtin_amdgcn_s_barrier()
#define G8_SCHED __builtin_amdgcn_sched_barrier(0)
    UnitG cur, nxt; int ui = 0;
    if (!S.next(0, cur)) return;
    f32x4 acc[2][2][4][2];
#pragma unroll
    for (int a = 0; a < 2; ++a)
#pragma unroll
        for (int b = 0; b < 2; ++b)
#pragma unroll
            for (int m = 0; m < 4; ++m)
#pragma unroll
                for (int n = 0; n < 2; ++n) acc[a][b][m][n] = (f32x4){0.f, 0.f, 0.f, 0.f};
    bf16x8 At[4][2], B0[2][2], B1[2][2];
    unsigned ao[2][2];
    const size_t hstepA = (size_t)HALF * S.pitch();
#pragma unroll
    for (int i = 0; i < 2; ++i) { ao[0][i] = S.aoff(0, R0 + 64 * i, C0 * 2); ao[1][i] = Sched::GATHER ? S.aoff(0, R0 + 64 * i + 128, C0 * 2) : 0u; }
    const char* cA = cur.A; const char* cB = cur.B;
    G8_STAGE(G8_SB(0, 0), cB, voffB); G8_STAGE(G8_SB(0, 1), cB + hstep, voffB); G8_STAGE_A(G8_SA(0, 0), cA, 0); G8_STAGE_A(G8_SA(0, 1), cA, 1);
    if (wr == 1) G8_BAR;
    G8_WAIT_V(2); G8_BAR;
    G8_STAGE(G8_SB(1, 0), cB + kstep, voffB); G8_STAGE_A(G8_SA(1, 0), cA + kstep, 0); G8_STAGE(G8_SB(1, 1), cB + hstep + kstep, voffB);
    G8_WAIT_V(6); G8_BAR;
    for (;;) {
        const bool has_next = S.next(ui + 1, nxt);
        const char* nA = has_next ? nxt.A : cA; const char* nB = has_next ? nxt.B : cB;
#pragma unroll 1
        for (int t = 0; t < nt; t += 2) {
            const bool last = (t == nt - 2);
            const char* a1 = cA + (size_t)(t + 1) * kstep;
            const char* a2 = last ? nA : cA + (size_t)(t + 2) * kstep; const char* b2 = last ? nB : cB + (size_t)(t + 2) * kstep;
            const char* a3 = a2 + kstep; const char* b3 = b2 + kstep;
            if constexpr (Sched::GATHER) { if (last && has_next) {
#pragma unroll
                for (int i = 0; i < 2; ++i) ao[0][i] = S.aoff(ui + 1, R0 + 64 * i, C0 * 2); } }
            G8_LDB(B0, 0, 0); G8_LDB(B1, 0, 1); G8_SCHED; G8_LDA(At, 0, 0); G8_STAGE_A(G8_SA(1, 1), a1, 1);
            if constexpr (Sched::GATHER) { if (last && has_next) {
#pragma unroll
                for (int i = 0; i < 2; ++i) ao[1][i] = S.aoff(ui + 1, R0 + 64 * i + 128, C0 * 2); } }
            G8_WAIT_V(8); G8_WAIT_L(0); G8_BAR; G8_MMA(0, 0, At, B0); G8_MMA(0, 1, At, B1); G8_BAR; G8_SCHED;
            G8_LDA(At, 0, 1); G8_STAGE(G8_SB(0, 0), b2, voffB); G8_STAGE(G8_SB(0, 1), b2 + hstep, voffB); G8_STAGE_A(G8_SA(0, 0), a2, 0);
            G8_WAIT_V(8); G8_WAIT_L(0); G8_BAR; G8_MMA(1, 0, At, B0); G8_MMA(1, 1, At, B1); G8_BAR; G8_SCHED;
            G8_LDB(B0, 1, 0); G8_LDB(B1, 1, 1); G8_SCHED; G8_LDA(At, 1, 0); G8_STAGE_A(G8_SA(0, 1), a2, 1);
            G8_WAIT_V(8); G8_WAIT_L(0); G8_BAR; G8_MMA(0, 0, At, B0); G8_MMA(0, 1, At, B1); G8_BAR; G8_SCHED;
            G8_LDA(At, 1, 1); G8_STAGE(G8_SB(1, 0), b3, voffB); G8_STAGE(G8_SB(1, 1), b3 + hstep, voffB); G8_STAGE_A(G8_SA(1, 0), a3, 0);
            G8_WAIT_V(8); G8_WAIT_L(0); G8_BAR; G8_MMA(1, 0, At, B0); G8_MMA(1, 1, At, B1); G8_BAR; G8_SCHED;
        }
        if (wr == 0) G8_BAR;
        E(acc, cur, wr, wc, fr, fq);
        if (!has_next) break;
#pragma unroll
        for (int a = 0; a < 2; ++a)
#pragma unroll
            for (int b = 0; b < 2; ++b)
#pragma unroll
                for (int m = 0; m < 4; ++m)
#pragma unroll
                    for (int n = 0; n < 2; ++n) acc[a][b][m][n] = (f32x4){0.f, 0.f, 0.f, 0.f};
        cur = nxt; cA = nA; cB = nB; ++ui;
        if (wr == 1) G8_BAR;
    }
    G8_WAIT_V(0);
    G8_BAR;
#undef G8_SA
#undef G8_SB
#undef G8_STAGE
#undef G8_STAGE_A
#undef G8_LDA
#undef G8_LDB
#undef G8_MMA
#undef G8_WAIT_V
#undef G8_WAIT_L
#undef G8_BAR
#undef G8_SCHED
}

struct DenseSched {
    const char* A; const char* Bt; char* O; int K, nM, nN, nwg, G, c, ldo, obytes;
    __device__ __forceinline__ void init(const void* A_, const void* Bt_, void* O_, int M, int N, int K_, int ldo_, int obytes_, int G_, int c_) {
        A = (const char*)A_; Bt = (const char*)Bt_; O = (char*)O_; K = K_; nM = M / BM; nN = N / BM; nwg = nM * nN; G = G_; c = c_; ldo = ldo_; obytes = obytes_; }
    __device__ __forceinline__ bool next(int i, UnitG& u) const {
        const long L = (long)i * G + c; if (L >= nwg) return false;
        int wgid = (int)L; { const int q = nwg / NXCD, r = nwg % NXCD, xcd = wgid % NXCD, off = wgid / NXCD; wgid = (xcd < r ? xcd * (q + 1) : r * (q + 1) + (xcd - r) * q) + off; }
        const int nig = WGM * nN, gid = wgid / nig, fm = gid * WGM, gsz = (nM - fm) < WGM ? (nM - fm) : WGM;
        const int pm = fm + ((wgid % nig) % gsz), pn = (wgid % nig) / gsz;
        u.p0 = pm; u.p1 = pn; u.p2 = 0; u.A = A + (size_t)pm * BM * K * 2; u.B = Bt + (size_t)pn * BM * K * 2;
        u.O = O + (size_t)pm * BM * ldo + (size_t)pn * BM * obytes; u.ldo = ldo; return true;
    }
    static constexpr bool GATHER = false;
    __device__ __forceinline__ int pitch() const { return K * 2; }
    __device__ __forceinline__ unsigned aoff(int, int row, int cb) const { return (unsigned)(row * K * 2 + cb); }
};
struct EpiBf16 {
    static constexpr bool PERM = true;
    __device__ __forceinline__ void operator()(const f32x4 (&acc)[2][2][4][2], const UnitG& u, int wr, int wc, int fr, int fq) const {
        asm volatile("" : "+v"(fr), "+v"(fq));
#pragma unroll
        for (int ai = 0; ai < 2; ++ai)
#pragma unroll
            for (int m = 0; m < 4; ++m) { char* rowp = u.O + (size_t)(ai * HALF + wr * 64 + m * 16 + fr) * u.ldo + (wc * 32 + 8 * fq) * 2;
#pragma unroll
                for (int bj = 0; bj < 2; ++bj) { const f32x4 v0 = acc[ai][bj][m][0], v1 = acc[ai][bj][m][1];
                    u32x4 w; w.x = cvt_pk_bf16(v0[0], v0[1]); w.y = cvt_pk_bf16(v0[2], v0[3]); w.z = cvt_pk_bf16(v1[0], v1[1]); w.w = cvt_pk_bf16(v1[2], v1[3]);
                    *(u32x4*)(rowp + bj * HALF * 2) = w; } }
    }
};
struct EpiF32 {
    static constexpr bool PERM = false;
    __device__ __forceinline__ void operator()(const f32x4 (&acc)[2][2][4][2], const UnitG& u, int wr, int wc, int fr, int fq) const {
        asm volatile("" : "+v"(fr), "+v"(fq));
#pragma unroll
        for (int ai = 0; ai < 2; ++ai)
#pragma unroll
            for (int m = 0; m < 4; ++m) { char* rowp = u.O + (size_t)(ai * HALF + wr * 64 + m * 16 + fr) * u.ldo + (wc * 32 + 4 * fq) * 4;
#pragma unroll
                for (int bj = 0; bj < 2; ++bj)
#pragma unroll
                    for (int n = 0; n < 2; ++n) *(f32x4*)(rowp + (bj * HALF + n * 16) * 4) = acc[ai][bj][m][n]; }
    }
};
struct EpiH {
    static constexpr bool PERM = true;
    __device__ __forceinline__ void operator()(const f32x4 (&acc)[2][2][4][2], const UnitG& u, int wr, int wc, int fr, int fq) const {
        asm volatile("" : "+v"(fr), "+v"(fq));
        const int valid = u.p1;
#pragma unroll
        for (int ai = 0; ai < 2; ++ai)
#pragma unroll
            for (int m = 0; m < 4; ++m) { const int r = ai * HALF + wr * 64 + m * 16 + fr;
                if (r < valid) {
                    const f32x4 g0 = acc[ai][0][m][0], g1 = acc[ai][0][m][1], u0 = acc[ai][1][m][0], u1 = acc[ai][1][m][1];
                    float h[8];
#pragma unroll
                    for (int j = 0; j < 4; ++j) { h[j] = siluf_(g0[j]) * u0[j]; h[4 + j] = siluf_(g1[j]) * u1[j]; }
                    *(u32x4*)(u.O + (size_t)r * u.ldo + (wc * 32 + 8 * fq) * 2) = pack8(h); } }
    }
};
struct EpiY {
    static constexpr bool PERM = true;
    const float* sgate;
    __device__ __forceinline__ void operator()(const f32x4 (&acc)[2][2][4][2], const UnitG& u, int wr, int wc, int fr, int fq) const {
        asm volatile("" : "+v"(fr), "+v"(fq));
        const int valid = u.p1, slot0 = u.p0; const bool shared = u.p2 != 0;
#pragma unroll
        for (int ai = 0; ai < 2; ++ai)
#pragma unroll
            for (int m = 0; m < 4; ++m) { const int r = ai * HALF + wr * 64 + m * 16 + fr;
                if (r < valid) {
                    const float gt = shared ? 1.0f : sgate[slot0 + r];
                    char* rowp = u.O + (size_t)r * u.ldo + (wc * 32 + 8 * fq) * 2;
#pragma unroll
                    for (int bj = 0; bj < 2; ++bj) { const f32x4 v0 = acc[ai][bj][m][0] * gt, v1 = acc[ai][bj][m][1] * gt;
                        u32x4 w; w.x = cvt_pk_bf16(v0[0], v0[1]); w.y = cvt_pk_bf16(v0[2], v0[3]); w.z = cvt_pk_bf16(v1[0], v1[1]); w.w = cvt_pk_bf16(v1[2], v1[3]);
                        *(u32x4*)(rowp + bj * HALF * 2) = w; } } }
    }
};
}

template <int OFF> __device__ __forceinline__ unsigned long long karg64() {
    unsigned long long v;
    asm volatile("s_load_dwordx2 %0, %1, %2\n\ts_waitcnt lgkmcnt(0)" : "=&s"(v) : "s"((unsigned long long)__builtin_amdgcn_kernarg_segment_ptr()), "n"(OFF) : "memory");
    return v;
}
template <int OFF> __device__ __forceinline__ int karg32() {
    int v;
    asm volatile("s_load_dword %0, %1, %2\n\ts_waitcnt lgkmcnt(0)" : "=&s"(v) : "s"((unsigned long long)__builtin_amdgcn_kernarg_segment_ptr()), "n"(OFF) : "memory");
    return v;
}
#define KIN(k) ((const float*)karg64<8 * (k)>())
#define KOUT() ((float*)karg64<176>())
#define KWS() ((unsigned char*)karg64<184>())
struct Args { const float* in[22]; float* out; unsigned char* ws; int ph_lo, ph_hi, li, pad; };
struct Frame {
    LAS unsigned char* lds;
    int tid, lane, wave, vcu, G;
};
static_assert(offsetof(Args, out) == 176 && offsetof(Args, ws) == 184 && offsetof(Args, ph_lo) == 192 && offsetof(Args, ph_hi) == 196, "Args layout");

enum { GT_BASE = 0, GT_N = 1, GT_TOT0 = 2, GT_YB0 = 3, GT_YB1 = 4, GT_TS1 = 5, GT_TS20 = 6, GT_TS21 = 7 };

__device__ __forceinline__ void tr_item(const float* W, int ldw, int k0, int c0, bf16* WT, int ldt, int drow0, LAS float* scr, int lane) {
#pragma unroll 8
    for (int i = 0; i < 32; ++i) { const int kk = 2 * i + (lane >> 5); scr[kk * 33 + (lane & 31)] = W[(size_t)(k0 + kk) * ldw + c0 + (lane & 31)]; }
    LDS_WAIT(); asm volatile("" ::: "memory");
    const int c = lane & 7;
#pragma unroll
    for (int j = 0; j < 4; ++j) { const int n = (lane >> 3) + 8 * j; const LAS float* s = scr + (8 * c) * 33 + n;
        u32x4 o; o.x = cvt_pk_bf16(s[0 * 33], s[1 * 33]); o.y = cvt_pk_bf16(s[2 * 33], s[3 * 33]); o.z = cvt_pk_bf16(s[4 * 33], s[5 * 33]); o.w = cvt_pk_bf16(s[6 * 33], s[7 * 33]);
        *(u32x4*)(WT + (size_t)(drow0 + n) * ldt + k0 + 8 * c) = o; }
    LDS_WAIT(); asm volatile("" ::: "memory");
}
__device__ __forceinline__ void tr_item64(const float* W, int ldw, int k0, int c0, bf16* WT, int ldt, int drow0, LAS float* scr, int lane) {
    f32x4 v[16];
#pragma unroll
    for (int i = 0; i < 16; ++i) v[i] = *(const f32x4*)(W + (size_t)(k0 + 4 * i + (lane >> 4)) * ldw + c0 + 4 * (lane & 15));
#pragma unroll
    for (int i = 0; i < 16; ++i) { LAS float* d = scr + (4 * i + (lane >> 4)) * 65 + 4 * (lane & 15); d[0] = v[i].x; d[1] = v[i].y; d[2] = v[i].z; d[3] = v[i].w; }
    LDS_WAIT(); asm volatile("" ::: "memory");
    const int c = lane & 7;
#pragma unroll
    for (int j = 0; j < 8; ++j) { const int n = (lane >> 3) + 8 * j; const LAS float* s = scr + (8 * c) * 65 + n;
        u32x4 o; o.x = cvt_pk_bf16(s[0 * 65], s[1 * 65]); o.y = cvt_pk_bf16(s[2 * 65], s[3 * 65]); o.z = cvt_pk_bf16(s[4 * 65], s[5 * 65]); o.w = cvt_pk_bf16(s[6 * 65], s[7 * 65]);
        *(u32x4*)(WT + (size_t)(drow0 + n) * ldt + k0 + 8 * c) = o; }
    LDS_WAIT(); asm volatile("" ::: "memory");
}
__device__ __forceinline__ void p0_prologue(Frame& F) {
    unsigned char* const ws_ = KWS(); float* const out_ = KOUT(); (void)ws_; (void)out_;
    const float* x = KIN(0); const float* meta = KIN(1); const float* w_in = KIN(2);
    LAS float* wbd = (LAS float*)(F.lds);
    LAS float* scr = (LAS float*)(F.lds + 32768 + F.wave * 8704);
    for (int i = F.tid; i < 8 * 1024; i += NTHREADS) { const int c = i >> 10, k = i & 1023; wbd[i] = w_in[(size_t)k * INC + NPJ + c]; }
    __syncthreads();
    const int gw = F.vcu * NWAVES + F.wave, NGW = F.G * NWAVES;
    bf16* xb = (bf16*)(ws_ + WS_RA); float* bd = (float*)(ws_ + TB_BD);
    for (int t = gw; t < T; t += NGW) {
        const f32x4* xr = (const f32x4*)(x + (size_t)t * D) + F.lane;
        f32x4 v[4];
#pragma unroll
        for (int j = 0; j < 4; ++j) v[j] = xr[64 * j];
        u32x2* o8 = (u32x2*)(xb + (size_t)t * D) + F.lane;
#pragma unroll
        for (int j = 0; j < 4; ++j) { u32x2 w; w.x = cvt_pk_bf16(v[j].x, v[j].y); w.y = cvt_pk_bf16(v[j].z, v[j].w); o8[64 * j] = w; }
        float s[8];
#pragma unroll
        for (int c = 0; c < 8; ++c) { float acc = 0.f;
#pragma unroll
            for (int j = 0; j < 4; ++j) { const f32x4 w = *(const LAS f32x4*)(wbd + c * 1024 + 256 * j + 4 * F.lane); acc += v[j].x * w.x + v[j].y * w.y + v[j].z * w.z + v[j].w * w.w; }
            s[c] = wave_sum(acc); }
        if (F.lane < 8) { float r = s[0];
#pragma unroll
            for (int c = 1; c < 8; ++c) r = (F.lane == c) ? s[c] : r;
            bd[(size_t)t * 8 + F.lane] = r; }
    }
    bf16* WinT = (bf16*)(ws_ + W_WINT); bf16* WoutT = (bf16*)(ws_ + W_WOUTT); bf16* WrT = (bf16*)(ws_ + W_WRT); bf16* Wsgu = (bf16*)(ws_ + W_WSGU); bf16* Wsd = (bf16*)(ws_ + W_WSD);
    constexpr int I_IN = 16 * 112, I_OUT = 16 * 32, I_R = 16 * 8, I_SG = 16 * 8, I_SU = 16 * 8, I_SD = 4 * 32;
    constexpr int NITEMS = I_IN + I_OUT + I_R + I_SG + I_SU + I_SD;
    for (int it = gw; it < NITEMS; it += NGW) {
        int r = it;
        if (r < I_IN) { const int kb = r / 112, nb = r % 112; tr_item(w_in, INC, 64 * kb, 32 * nb, WinT, D, 32 * nb, scr, F.lane); continue; } r -= I_IN;
        if (r < I_OUT) { const int kb = r / 32, nb = r % 32; tr_item(KIN(9), D, 64 * kb, 32 * nb, WoutT, D, 32 * nb, scr, F.lane); continue; } r -= I_OUT;
        if (r < I_R) { const int kb = r / 8, nb = r % 8; tr_item(KIN(12), NE, 64 * kb, 32 * nb, WrT, D, 32 * nb, scr, F.lane); continue; } r -= I_R;
        if (r < I_SG) { const int kb = r / 8, nb = r % 8; tr_item(KIN(17), EFF, 64 * kb, 32 * nb, Wsgu, D, 256 * (nb >> 2) + 32 * (nb & 3), scr, F.lane); continue; } r -= I_SG;
        if (r < I_SU) { const int kb = r / 8, nb = r % 8; tr_item(KIN(18), EFF, 64 * kb, 32 * nb, Wsgu, D, 256 * (nb >> 2) + 128 + 32 * (nb & 3), scr, F.lane); continue; } r -= I_SU;
        { const int kb = r / 32, nb = r % 32; tr_item(KIN(19), D, 64 * kb, 32 * nb, Wsd, EFF, 32 * nb, scr, F.lane); }
    }
    float* projm = (float*)(ws_ + TB_PROJM);
    for (int idx = F.vcu * NTHREADS + F.tid; idx < INC * 4; idx += F.G * NTHREADS) {
        const int col = idx % INC, rg = idx / INC;
        float acc[4] = {0.f, 0.f, 0.f, 0.f};
        for (int k = 0; k < D; ++k) { const float w = w_in[(size_t)k * INC + col];
#pragma unroll
            for (int r = 0; r < 4; ++r) acc[r] += meta[(rg * 4 + r) * D + k] * w; }
#pragma unroll
        for (int r = 0; r < 4; ++r) projm[(rg * 4 + r) * INC + col] = acc[r];
    }
}

__device__ __forceinline__ void p2_ld8(const bf16* proj, const float* projm, bool metarun, int b, int pos, int col, float (&o)[8]) {
    if (pos < 0 && metarun) {
#pragma unroll
        for (int j = 0; j < 8; ++j) o[j] = 0.f;
        return; }
    if (pos < 0 || metarun) { const int p = metarun ? pos : 16 + pos; const f32x4* s = (const f32x4*)(projm + (size_t)p * INC + col); const f32x4 a0 = s[0], a1 = s[1];
        o[0] = a0.x; o[1] = a0.y; o[2] = a0.z; o[3] = a0.w; o[4] = a1.x; o[5] = a1.y; o[6] = a1.z; o[7] = a1.w; return; }
    const u32x4 w = *(const u32x4*)(proj + (size_t)(b * SEQ + pos) * NPJ + col); unpack8(w, o);
}
__device__ __forceinline__ void p2_prep(Frame& F) {
    unsigned char* const ws_ = KWS(); float* const out_ = KOUT(); (void)ws_; (void)out_;
    const bf16* proj = (const bf16*)(ws_ + WS_RB); const float* projm = (const float*)(ws_ + TB_PROJM); const float* bd = (const float*)(ws_ + TB_BD);
    bf16* ycat = (bf16*)(ws_ + WS_RA); bf16* qn = (bf16*)(ws_ + WS_QN); bf16* kn = (bf16*)(ws_ + WS_KN); bf16* vv = (bf16*)(ws_ + WS_VV); bf16* zb = (bf16*)(ws_ + WS_ZB);
    float* betab = (float*)(ws_ + TB_BETA); float* gb = (float*)(ws_ + TB_G);
    bf16* mq = (bf16*)(ws_ + TB_METAQ); bf16* mk = (bf16*)(ws_ + TB_METAK); bf16* mv = (bf16*)(ws_ + TB_METAV); float* mbeta = (float*)(ws_ + TB_METAB); float* mg = (float*)(ws_ + TB_METAG);
    const float* conv_w = KIN(3); const float* conv_nw = KIN(4); const float* gconv_w = KIN(5); const float* a_log = KIN(6); const float* dt_bias = KIN(7);
    const int gw = F.vcu * NWAVES + F.wave, NGW = F.G * NWAVES, lane = F.lane, ch = 8 * lane;
    for (int rid = gw; rid < 2049; rid += NGW) {
        const bool metarun = (rid == 2048);
        const int b = metarun ? 0 : (rid >> 6), s0 = metarun ? 0 : (rid & 63) * 32, len = metarun ? 16 : 32;
        if (metarun) {
            for (int r = 0; r < 48; ++r) { const u32x4 z = (u32x4){0u, 0u, 0u, 0u}; *(u32x4*)(mq + r * 512 + ch) = z; *(u32x4*)(mk + r * 512 + ch) = z; *(u32x4*)(mv + r * 512 + ch) = z; }
            for (int i = lane; i < 48 * 4; i += 64) { mbeta[i] = 0.f; mg[i] = 0.f; }
        }
        if (!metarun) {
            float w0[8], w1[8], w2[8], nw[8];
#pragma unroll
            for (int j = 0; j < 8; ++j) { w0[j] = conv_w[ch + j]; w1[j] = conv_w[CW + ch + j]; w2[j] = conv_w[2 * CW + ch + j]; nw[j] = conv_nw[ch + j]; }
            float c2[8], c1[8], t0[8], t1[8];
            p2_ld8(proj, projm, false, b, s0 - 2, CW + ch, t0); p2_ld8(proj, projm, false, b, s0 - 2, 2 * CW + ch, t1);
#pragma unroll
            for (int j = 0; j < 8; ++j) c2[j] = t0[j] * t1[j];
            p2_ld8(proj, projm, false, b, s0 - 1, CW + ch, t0); p2_ld8(proj, projm, false, b, s0 - 1, 2 * CW + ch, t1);
#pragma unroll
            for (int j = 0; j < 8; ++j) c1[j] = t0[j] * t1[j];
#pragma unroll 1
            for (int s = s0; s < s0 + 32; s += 2) {
                u32x4 la[2], lb_[2], lc[2], lz[2];
#pragma unroll
                for (int u = 0; u < 2; ++u) { const bf16* rowp = proj + (size_t)(b * SEQ + s + u) * NPJ + ch;
                    la[u] = *(const u32x4*)(rowp + CW); lb_[u] = *(const u32x4*)(rowp + 2 * CW); lc[u] = *(const u32x4*)(rowp); lz[u] = *(const u32x4*)(rowp + 3072); }
#pragma unroll
                for (int u = 0; u < 2; ++u) {
                    float gbv[8], y[8], c0[8];
                    unpack8(la[u], t0); unpack8(lb_[u], t1); unpack8(lc[u], gbv);
                    float ss = 0.f;
#pragma unroll
                    for (int j = 0; j < 8; ++j) { c0[j] = t0[j] * t1[j]; y[j] = gbv[j] * (w0[j] * c2[j] + w1[j] * c1[j] + w2[j] * c0[j]); ss += y[j] * y[j]; c2[j] = c1[j]; c1[j] = c0[j]; }
                    ss = wave_sum(ss);
                    const float rms = 1.0f / sqrtf(ss * (1.0f / CW) + EPS);
#pragma unroll
                    for (int j = 0; j < 8; ++j) y[j] = y[j] * rms * nw[j];
                    *(u32x4*)(ycat + (size_t)(b * SEQ + s + u) * D + ch) = pack8(y);
                    *(u32x4*)(zb + (size_t)(b * SEQ + s + u) * GWID + ch) = lz[u];
                }
            }
        }
#pragma unroll 1
        for (int p = 0; p < 3; ++p) {
            const int cb = 1536 + 512 * p + ch;
            float w0[8], w1[8], w2[8], w3[8];
#pragma unroll
            for (int j = 0; j < 8; ++j) { w0[j] = gconv_w[512 * p + ch + j]; w1[j] = gconv_w[1536 + 512 * p + ch + j]; w2[j] = gconv_w[2 * 1536 + 512 * p + ch + j]; w3[j] = gconv_w[3 * 1536 + 512 * p + ch + j]; }
            float r3[8], r2[8], r1[8], r0[8];
            p2_ld8(proj, projm, metarun, b, s0 - 3, cb, r3); p2_ld8(proj, projm, metarun, b, s0 - 2, cb, r2); p2_ld8(proj, projm, metarun, b, s0 - 1, cb, r1);
            bf16* dst = metarun ? (p == 0 ? mq : (p == 1 ? mk : mv)) : (p == 0 ? qn : (p == 1 ? kn : vv));
#pragma unroll 1
            for (int s = s0; s < s0 + len; s += 4) {
                u32x4 lr[4];
                if (!metarun) {
#pragma unroll
                    for (int u = 0; u < 4; ++u) lr[u] = *(const u32x4*)(proj + (size_t)(b * SEQ + s + u) * NPJ + cb);
                }
#pragma unroll
                for (int u = 0; u < 4; ++u) {
                    if (metarun) p2_ld8(proj, projm, true, b, s + u, cb, r0); else unpack8(lr[u], r0);
                    float y[8]; float ss = 0.f;
#pragma unroll
                    for (int j = 0; j < 8; ++j) { const float c = w0[j] * r3[j] + w1[j] * r2[j] + w2[j] * r1[j] + w3[j] * r0[j]; y[j] = siluf_(c); ss += y[j] * y[j]; r3[j] = r2[j]; r2[j] = r1[j]; r1[j] = r0[j]; }
                    if (p < 2) {
                        ss += __shfl_xor(ss, 1); ss += __shfl_xor(ss, 2); ss += __shfl_xor(ss, 4); ss += __shfl_xor(ss, 8);
                        const float sc = (1.0f / sqrtf(ss + 1e-6f)) * (p == 0 ? 0.08838834764831845f : 1.0f);
#pragma unroll
                        for (int j = 0; j < 8; ++j) y[j] *= sc;
                    }
                    const size_t row = metarun ? (size_t)(48 + s + u) : (size_t)(b * SEQ + s + u);
                    *(u32x4*)(dst + row * GWID + ch) = pack8(y);
                }
            }
        }
        for (int i = lane; i < len * 8; i += 64) {
            const int s = s0 + (i >> 3), c = i & 7, h = c & 3;
            const float v = metarun ? projm[(size_t)s * INC + NPJ + c] : bd[(size_t)(b * SEQ + s) * 8 + c];
            const size_t row = metarun ? (size_t)(48 + s) : (size_t)(b * SEQ + s);
            if (c < 4) { const float be = 1.0f / (1.0f + expf(-v)); (metarun ? mbeta : betab)[row * 4 + h] = be; }
            else { const float xx = v + dt_bias[h]; const float sp = fmaxf(xx, 0.f) + log1pf(expf(-fabsf(xx))); (metarun ? mg : gb)[row * 4 + h] = -expf(a_log[h]) * sp; }
        }
    }
}

__device__ __forceinline__ int perm_pos(int d) { return (d & ~31) | (((d >> 2) & 3) << 3) | (((d >> 4) & 1) << 2) | (d & 3); }
constexpr int P3_QT = 0, P3_KT = 17408, P3_LT = 34816, P3_SC = 51200, P3_OUT = 52224;
__device__ __forceinline__ void p3_gdn_local(Frame& F) {
    unsigned char* const ws_ = KWS(); float* const out_ = KOUT(); (void)ws_; (void)out_;
    LAS unsigned char* lds = F.lds;
    const int wave = F.wave;
    LAS float* sc_gc = (LAS float*)(lds + P3_SC);
    LAS float* sc_beta = sc_gc + 64;
    LAS float* sc_g = sc_gc + 128;
    LAS float* LT = (LAS float*)(lds + P3_LT);
    for (int unit = F.vcu; unit < 4100; unit += F.G) {
        int tid = F.tid; asm volatile("" : "+v"(tid));
        int lane = tid & 63;
        const bool metau = unit >= 4096;
        const int h = unit & 3, bc = unit >> 2;
        const size_t row0 = metau ? 0 : (size_t)bc * 64;
        const bf16* qp = metau ? (const bf16*)(ws_ + TB_METAQ) : (const bf16*)(ws_ + WS_QN);
        const bf16* kp = metau ? (const bf16*)(ws_ + TB_METAK) : (const bf16*)(ws_ + WS_KN);
        const bf16* vp = metau ? (const bf16*)(ws_ + TB_METAV) : (const bf16*)(ws_ + WS_VV);
        const float* gp = metau ? (const float*)(ws_ + TB_METAG) : (const float*)(ws_ + TB_G);
        const float* bp = metau ? (const float*)(ws_ + TB_METAB) : (const float*)(ws_ + TB_BETA);
        unsigned char* blk = ws_ + WS_RB + (size_t)unit * GBLK;
#pragma unroll
        for (int i = 0; i < 2; ++i) { const int p = tid + 512 * i, r = p >> 4, c16 = p & 15;
            *(LAS u32x4*)(lds + P3_QT + r * 272 + c16 * 16) = *(const u32x4*)(qp + (row0 + r) * GWID + h * HD + c16 * 8);
            *(LAS u32x4*)(lds + P3_KT + r * 272 + c16 * 16) = *(const u32x4*)(kp + (row0 + r) * GWID + h * HD + c16 * 8); }
        if (tid < 64) sc_g[tid] = gp[(row0 + tid) * 4 + h];
        else if (tid < 128) sc_beta[tid - 64] = bp[(row0 + tid - 64) * 4 + h];
        __syncthreads();
        float gcl = sc_g[lane];
#pragma unroll
        for (int o = 1; o < 64; o <<= 1) { const float y = __shfl_up(gcl, o); if (lane >= o) gcl += y; }
        sc_gc[lane] = gcl;
        LDS_WAIT(); asm volatile("" ::: "memory");
        const float glast = __shfl(gcl, 63);
        {
            const int fr = lane & 15, fq = lane >> 4, mt = wave >> 1;
#pragma unroll
            for (int tn = 0; tn < 2; ++tn) {
                const int ntl = 2 * (wave & 1) + tn;
                f32x4 akk = (f32x4){0.f, 0.f, 0.f, 0.f}, aqk = (f32x4){0.f, 0.f, 0.f, 0.f};
#pragma unroll
                for (int s = 0; s < 4; ++s) {
                    const bf16x8 ki = *(const LAS bf16x8*)(lds + P3_KT + (16 * mt + fr) * 272 + (32 * s + 8 * fq) * 2);
                    const bf16x8 qi = *(const LAS bf16x8*)(lds + P3_QT + (16 * mt + fr) * 272 + (32 * s + 8 * fq) * 2);
                    const bf16x8 kj = *(const LAS bf16x8*)(lds + P3_KT + (16 * ntl + fr) * 272 + (32 * s + 8 * fq) * 2);
                    akk = __builtin_amdgcn_mfma_f32_16x16x32_bf16(ki, kj, akk, 0, 0, 0);
                    aqk = __builtin_amdgcn_mfma_f32_16x16x32_bf16(qi, kj, aqk, 0, 0, 0);
                }
                const int j = 16 * ntl + fr; const float gcj = sc_gc[j];
                f32x4 lv;
#pragma unroll
                for (int jj = 0; jj < 4; ++jj) { const int i = 16 * mt + 4 * fq + jj; const float dec = fast_exp(fminf(sc_gc[i] - gcj, 0.f));
                    lv[jj] = (i > j) ? sc_beta[i] * akk[jj] * dec : 0.f;
                    const float at = (i >= j) ? aqk[jj] * dec : 0.f;
                    *(LAS bf16*)(lds + P3_OUT + GB_ATT + i * 144 + perm_pos(j) * 2) = (bf16)(cvt_pk_bf16(at, 0.f) & 0xffffu); }
                *(LAS f32x4*)(LT + j * 64 + 16 * mt + 4 * fq) = lv;
            }
        }
        __syncthreads();
        asm volatile("" : "+v"(tid));
        if (tid < 256) {
            const bool isu = tid < 128; const int pos = perm_pos(tid - 128);
#pragma unroll 1
            for (int I = 0; I < 4; ++I) {
                float r[16];
                if (isu) {
#pragma unroll
                    for (int ii = 0; ii < 16; ++ii) r[ii] = sc_beta[16 * I + ii] * bf2f(vp[(row0 + 16 * I + ii) * GWID + h * HD + tid]);
                } else {
#pragma unroll
                    for (int ii = 0; ii < 16; ++ii) r[ii] = sc_beta[16 * I + ii] * fast_exp(sc_gc[16 * I + ii]) * bf2f(*(const LAS bf16*)(lds + P3_KT + (16 * I + ii) * 272 + (tid - 128) * 2));
                }
#pragma unroll 1
                for (int J = 0; J < I; ++J) {
                    float xs[16];
                    if (isu) { float t8[8];
                        unpack8(*(const LAS u32x4*)(lds + P3_OUT + GB_UT + tid * 144 + 32 * J), t8);
#pragma unroll
                        for (int q = 0; q < 8; ++q) xs[q] = t8[q];
                        unpack8(*(const LAS u32x4*)(lds + P3_OUT + GB_UT + tid * 144 + 32 * J + 16), t8);
#pragma unroll
                        for (int q = 0; q < 8; ++q) xs[8 + q] = t8[q];
                    } else {
#pragma unroll
                        for (int jj = 0; jj < 16; ++jj) xs[jj] = -bf2f(*(const LAS bf16*)(lds + P3_OUT + GB_WP + (16 * J + jj) * 272 + pos * 2));
                    }
#pragma unroll
                    for (int jj = 0; jj < 16; ++jj)
#pragma unroll
                        for (int q4 = 0; q4 < 4; ++q4) { const f32x4 l = *(const LAS f32x4*)(LT + (16 * J + jj) * 64 + 16 * I + 4 * q4);
                            r[4 * q4 + 0] -= l.x * xs[jj]; r[4 * q4 + 1] -= l.y * xs[jj]; r[4 * q4 + 2] -= l.z * xs[jj]; r[4 * q4 + 3] -= l.w * xs[jj]; }
                }
#pragma unroll
                for (int jj = 0; jj < 15; ++jj) { const float xj = r[jj];
#pragma unroll
                    for (int i4 = ((jj + 1) & ~3); i4 < 16; i4 += 4) { const f32x4 l = *(const LAS f32x4*)(LT + (16 * I + jj) * 64 + 16 * I + i4);
                        r[i4 + 0] -= l.x * xj; r[i4 + 1] -= l.y * xj; r[i4 + 2] -= l.z * xj; r[i4 + 3] -= l.w * xj; } }
                if (isu) {
#pragma unroll
                    for (int c8 = 0; c8 < 2; ++c8) { u32x4 w; w.x = cvt_pk_bf16(r[8 * c8 + 0], r[8 * c8 + 1]); w.y = cvt_pk_bf16(r[8 * c8 + 2], r[8 * c8 + 3]); w.z = cvt_pk_bf16(r[8 * c8 + 4], r[8 * c8 + 5]); w.w = cvt_pk_bf16(r[8 * c8 + 6], r[8 * c8 + 7]);
                        *(LAS u32x4*)(lds + P3_OUT + GB_UT + tid * 144 + 32 * I + c8 * 16) = w; }
                } else {
#pragma unroll
                    for (int ii = 0; ii < 16; ++ii) *(LAS bf16*)(lds + P3_OUT + GB_WP + (16 * I + ii) * 272 + pos * 2) = (bf16)(cvt_pk_bf16(-r[ii], 0.f) & 0xffffu);
                }
                asm volatile("" ::: "memory");
            }
        } else {
            const int tt = tid - 256;
            {
                const int c = tt >> 2, s = tt & 3; const float e = fast_exp(sc_gc[c]);
                float v[32];
#pragma unroll
                for (int g4 = 0; g4 < 4; ++g4) { const u32x4 w = *(const LAS u32x4*)(lds + P3_QT + c * 272 + (32 * s + 8 * g4) * 2); float t8[8]; unpack8(w, t8);
#pragma unroll
                    for (int j = 0; j < 8; ++j) v[8 * g4 + j] = t8[j] * e; }
#pragma unroll
                for (int q = 0; q < 4; ++q) { float o8[8];
#pragma unroll
                    for (int j = 0; j < 8; ++j) o8[j] = v[16 * (j >> 2) + 4 * q + (j & 3)];
                    *(LAS u32x4*)(lds + P3_OUT + GB_QD + c * 272 + (32 * s + 8 * q) * 2) = pack8(o8); }
            }
            {
                const int dk = tt >> 1, s = tt & 1;
                float v[32];
#pragma unroll
                for (int i = 0; i < 32; ++i) { const int c = 32 * s + i; v[i] = bf2f(*(const LAS bf16*)(lds + P3_KT + c * 272 + dk * 2)) * fast_exp(glast - sc_gc[c]); }
#pragma unroll
                for (int q = 0; q < 4; ++q) { float o8[8];
#pragma unroll
                    for (int j = 0; j < 8; ++j) o8[j] = v[16 * (j >> 2) + 4 * q + (j & 3)];
                    *(LAS u32x4*)(lds + P3_OUT + GB_KDT + dk * 144 + (32 * s + 8 * q) * 2) = pack8(o8); }
            }
        }
        __syncthreads();
        if (GDN_PROBE) {
            unsigned flags = 0u;
            { const int i = tid >> 3;
              for (int jj = 0; jj < 8; ++jj) { const int j = (tid & 7) * 8 + jj; float dq = 0.f, dkk = 0.f;
                  for (int d = 0; d < 128; ++d) { const float kj = bf2f(*(const LAS bf16*)(lds + P3_KT + j * 272 + d * 2)); dq += bf2f(*(const LAS bf16*)(lds + P3_QT + i * 272 + d * 2)) * kj; dkk += bf2f(*(const LAS bf16*)(lds + P3_KT + i * 272 + d * 2)) * kj; }
                  const float dec = (i >= j) ? expf(sc_gc[i] - sc_gc[j]) : 0.f;
                  const float ra = (i >= j) ? dq * dec : 0.f, ga = bf2f(*(const LAS bf16*)(lds + P3_OUT + GB_ATT + i * 144 + perm_pos(j) * 2));
                  if (!(fabsf(ga - ra) <= 0.02f * fabsf(ra) + 1e-4f)) flags |= 1u;
                  const float rl = (i > j) ? sc_beta[i] * dkk * dec : 0.f, gl = LT[j * 64 + i];
                  if (!(fabsf(gl - rl) <= 2e-3f * fabsf(rl) + 1e-5f)) flags |= 2u; } }
            { const int c = tid >> 3;
              for (int x = 0; x < 16; ++x) { const int dk = (tid & 7) * 16 + x;
                  const float rq = bf2f(*(const LAS bf16*)(lds + P3_QT + c * 272 + dk * 2)) * expf(sc_gc[c]), gq = bf2f(*(const LAS bf16*)(lds + P3_OUT + GB_QD + c * 272 + perm_pos(dk) * 2));
                  if (!(fabsf(gq - rq) <= 0.02f * fabsf(rq) + 1e-6f)) flags |= 4u;
                  const float rk = bf2f(*(const LAS bf16*)(lds + P3_KT + c * 272 + dk * 2)) * expf(glast - sc_gc[c]), gk = bf2f(*(const LAS bf16*)(lds + P3_OUT + GB_KDT + dk * 144 + perm_pos(c) * 2));
                  if (!(fabsf(gk - rk) <= 0.02f * fabsf(rk) + 1e-6f)) flags |= 8u; } }
            if (tid < 256) {
#define XS(i) (tid < 128 ? bf2f(*(const LAS bf16*)(lds + P3_OUT + GB_UT + tid * 144 + (i) * 2)) : -bf2f(*(const LAS bf16*)(lds + P3_OUT + GB_WP + (i) * 272 + perm_pos(tid - 128) * 2)))
#pragma unroll 1
                for (int i = 0; i < 64; ++i) {
                    const float rhs = tid < 128 ? sc_beta[i] * bf2f(vp[(row0 + i) * GWID + h * HD + tid]) : sc_beta[i] * expf(sc_gc[i]) * bf2f(*(const LAS bf16*)(lds + P3_KT + i * 272 + (tid - 128) * 2));
                    const float xi = XS(i); float acc = xi, mag = fabsf(rhs) + fabsf(xi);
#pragma unroll 1
                    for (int j = 0; j < i; ++j) { const float tl = LT[j * 64 + i] * XS(j); acc += tl; mag += fabsf(tl); }
                    if (!(fabsf(acc - rhs) <= 0.03f * mag + 1e-5f)) flags |= (tid < 128 ? 16u : 32u);
                }
#undef XS
            }
            if (flags) atomicOr((unsigned*)(ws_ + WS_CTL) + CW_DBG, flags);
        }
        asm volatile("" : "+v"(tid));
        for (int p = tid; p < GB_EG / 16; p += NTHREADS) { const u32x4 w = *(const LAS u32x4*)(lds + P3_OUT + p * 16); *(u32x4*)(blk + p * 16) = w;
 }
        if (tid == 0) *(float*)(blk + GB_EG) = fast_exp(glast);
        __syncthreads();
    }
}

constexpr int P4_IN = 0, P4_OT = 81920;
__device__ __forceinline__ void p4_gdn_scan(Frame& F) {
    unsigned char* const ws_ = KWS(); float* const out_ = KOUT(); (void)ws_; (void)out_;
    if (F.vcu >= BATCH * NHEAD) return;
    LAS unsigned char* lds = F.lds;
    const int tid = F.tid, lane = F.lane, wv = F.wave, fr = lane & 15, fq = lane >> 4;
    const int b = F.vcu >> 2, h = F.vcu & 3;
    const float* gnw = KIN(8);
    const bf16* zb = (const bf16*)(ws_ + WS_ZB); bf16* ycat = (bf16*)(ws_ + WS_RA);
    const unsigned char* gbase = ws_ + WS_RB;
    f32x4 S[8]; bf16x8 Sb[4];
#pragma unroll
    for (int i = 0; i < 8; ++i) S[i] = (f32x4){0.f, 0.f, 0.f, 0.f};
#pragma unroll
    for (int i = 0; i < 4; ++i) Sb[i] = (bf16x8){0, 0, 0, 0, 0, 0, 0, 0};
    constexpr int NPIECE = GBLK / 16;
    u32x4 pre[10];
    {
        const unsigned char* blk = gbase + (size_t)(4096 + h) * GBLK;
#pragma unroll
        for (int i = 0; i < 10; ++i) pre[i] = *(const u32x4*)(blk + (size_t)(tid + 512 * i) * 16);
#pragma unroll
        for (int i = 0; i < 10; ++i) *(LAS u32x4*)(lds + P4_IN + (tid + 512 * i) * 16) = pre[i];
    }
    __syncthreads();
    for (int n = 0; n <= 32; ++n) {
        if (n < 32) {
            const unsigned char* blk = gbase + (size_t)(((b * 32 + n) * 4) + h) * GBLK;
#pragma unroll
            for (int i = 0; i < 10; ++i) pre[i] = *(const u32x4*)(blk + (size_t)(tid + 512 * i) * 16);
        }
        const float eg = *(const LAS float*)(lds + P4_IN + GB_EG);
        f32x4 o[4], v[4];
#pragma unroll
        for (int mt = 0; mt < 4; ++mt) { o[mt] = (f32x4){0.f, 0.f, 0.f, 0.f};
            const u32x2 w = *(const LAS u32x2*)(lds + P4_IN + GB_UT + (16 * wv + fr) * 144 + (16 * mt + 4 * fq) * 2);
            v[mt] = (f32x4){bf_lo(w.x), bf_hi(w.x), bf_lo(w.y), bf_hi(w.y)}; }
#pragma unroll
        for (int s = 0; s < 4; ++s)
#pragma unroll
            for (int mt = 0; mt < 4; ++mt) {
                const bf16x8 aw = *(const LAS bf16x8*)(lds + P4_IN + GB_WP + (16 * mt + fr) * 272 + (32 * s + 8 * fq) * 2);
                const bf16x8 aq = *(const LAS bf16x8*)(lds + P4_IN + GB_QD + (16 * mt + fr) * 272 + (32 * s + 8 * fq) * 2);
                v[mt] = __builtin_amdgcn_mfma_f32_16x16x32_bf16(aw, Sb[s], v[mt], 0, 0, 0);
                o[mt] = __builtin_amdgcn_mfma_f32_16x16x32_bf16(aq, Sb[s], o[mt], 0, 0, 0);
            }
        bf16x8 vb[2];
#pragma unroll
        for (int s2 = 0; s2 < 2; ++s2) { u32x4 w; w.x = cvt_pk_bf16(v[2 * s2][0], v[2 * s2][1]); w.y = cvt_pk_bf16(v[2 * s2][2], v[2 * s2][3]); w.z = cvt_pk_bf16(v[2 * s2 + 1][0], v[2 * s2 + 1][1]); w.w = cvt_pk_bf16(v[2 * s2 + 1][2], v[2 * s2 + 1][3]);
            vb[s2] = __builtin_bit_cast(bf16x8, w); }
#pragma unroll
        for (int s2 = 0; s2 < 2; ++s2)
#pragma unroll
            for (int mt = 0; mt < 4; ++mt) {
                const bf16x8 at = *(const LAS bf16x8*)(lds + P4_IN + GB_ATT + (16 * mt + fr) * 144 + (32 * s2 + 8 * fq) * 2);
                o[mt] = __builtin_amdgcn_mfma_f32_16x16x32_bf16(at, vb[s2], o[mt], 0, 0, 0);
            }
#pragma unroll
        for (int dt = 0; dt < 8; ++dt) { S[dt] = S[dt] * eg;
#pragma unroll
            for (int s2 = 0; s2 < 2; ++s2) {
                const bf16x8 ak = *(const LAS bf16x8*)(lds + P4_IN + GB_KDT + (16 * dt + fr) * 144 + (32 * s2 + 8 * fq) * 2);
                S[dt] = __builtin_amdgcn_mfma_f32_16x16x32_bf16(ak, vb[s2], S[dt], 0, 0, 0);
            } }
#pragma unroll
        for (int s = 0; s < 4; ++s) { u32x4 w; w.x = cvt_pk_bf16(S[2 * s][0], S[2 * s][1]); w.y = cvt_pk_bf16(S[2 * s][2], S[2 * s][3]); w.z = cvt_pk_bf16(S[2 * s + 1][0], S[2 * s + 1][1]); w.w = cvt_pk_bf16(S[2 * s + 1][2], S[2 * s + 1][3]);
            Sb[s] = __builtin_bit_cast(bf16x8, w); }
        if (n >= 1) {
#pragma unroll
            for (int mt = 0; mt < 4; ++mt)
#pragma unroll
                for (int jj = 0; jj < 4; ++jj) *(LAS float*)(lds + P4_OT + ((16 * mt + 4 * fq + jj) * 132 + 16 * wv + fr) * 4) = o[mt][jj];
        }
        __syncthreads();
        if (GDN_PROBE && n == 0) { bool bad = false;
#pragma unroll
            for (int dt = 0; dt < 8; ++dt)
#pragma unroll
                for (int j = 0; j < 4; ++j) bad |= !(fabsf(S[dt][j]) < 1e30f);
            if (bad) atomicOr((unsigned*)(ws_ + WS_CTL) + CW_DBG, 64u); }
        if (GDN_PROBE && n >= 1) {
            const int row = tid >> 3, part = tid & 7; const size_t t = (size_t)b * SEQ + 64 * (n - 1) + row; const float* ob = (const float*)KOUT() + t * GWID + h * HD + 16 * part;
            float es = 0.f, rs = 0.f; bool bad = false;
#pragma unroll
            for (int q = 0; q < 16; ++q) { const float oc = *(const LAS float*)(lds + P4_OT + (row * 132 + 16 * part + q) * 4), orf = ob[q]; bad |= !(fabsf(oc) < 1e30f); es += (oc - orf) * (oc - orf); rs += orf * orf; }
            es = wave_sum(es); rs = wave_sum(rs);
            if (bad || es > 0.01f * rs) atomicOr((unsigned*)(ws_ + WS_CTL) + CW_DBG, 128u << (n - 1 < 3 ? n - 1 : 3));
        }
        if (!GDN_PROBE && n >= 1) {
            const int row = tid >> 3, part = tid & 7;
            float ov[16]; float ss = 0.f;
#pragma unroll
            for (int q = 0; q < 4; ++q) { const f32x4 t4 = *(const LAS f32x4*)(lds + P4_OT + (row * 132 + 16 * part + 4 * q) * 4); ov[4 * q] = t4.x; ov[4 * q + 1] = t4.y; ov[4 * q + 2] = t4.z; ov[4 * q + 3] = t4.w; }
#pragma unroll
            for (int j = 0; j < 16; ++j) ss += ov[j] * ov[j];
            ss += __shfl_xor(ss, 1); ss += __shfl_xor(ss, 2); ss += __shfl_xor(ss, 4);
            const float rms = 1.0f / sqrtf(ss * (1.0f / HD) + EPS);
            const size_t t = (size_t)b * SEQ + 64 * (n - 1) + row;
            float z8[8];
#pragma unroll
            for (int hh = 0; hh < 2; ++hh) {
                unpack8(*(const u32x4*)(zb + t * GWID + h * HD + 16 * part + 8 * hh), z8);
                float o8[8];
#pragma unroll
                for (int j = 0; j < 8; ++j) { o8[j] = ov[8 * hh + j] * rms * gnw[16 * part + 8 * hh + j] * siluf_(z8[j]); if (DBG_STAGE == 5 && !(fabsf(o8[j]) < 1e30f)) o8[j] = 0.f; }
                *(u32x4*)(ycat + t * D + CW + h * HD + 16 * part + 8 * hh) = pack8(o8);
            }
        }
        if (n < 32) {
#pragma unroll
            for (int i = 0; i < 10; ++i) *(LAS u32x4*)(lds + P4_IN + (tid + 512 * i) * 16) = pre[i];
        }
        __syncthreads();
    }
}


#ifndef GDN_RECURRENT
#define GDN_RECURRENT 0
#endif

__device__ __forceinline__ void p3_gdn_recurrent(Frame& F) {
    unsigned char* const ws_ = KWS();
    LAS float* lk = (LAS float*)(F.lds); LAS float* lq = lk + 64 * 128; LAS float* lv = lq + 64 * 128; LAS float* lb = lv + 64 * 64; LAS float* lg = lb + 64;
    const int tid = F.tid, dvl = tid >> 3, part = tid & 7;
    const int b = F.vcu >> 3, h = (F.vcu >> 1) & 3, dvh = F.vcu & 1;
    float* obuf = KOUT();
    float S[16];
#pragma unroll
    for (int i = 0; i < 16; ++i) S[i] = 0.f;
    for (int grp = 0; grp <= 32; ++grp) {
        const bool mg_ = (grp == 0); const int ntok = mg_ ? 16 : 64;
        const size_t row0 = mg_ ? 48 : (size_t)b * SEQ + 64 * (grp - 1);
        const bf16* qp = mg_ ? (const bf16*)(ws_ + TB_METAQ) : (const bf16*)(ws_ + WS_QN);
        const bf16* kp = mg_ ? (const bf16*)(ws_ + TB_METAK) : (const bf16*)(ws_ + WS_KN);
        const bf16* vp = mg_ ? (const bf16*)(ws_ + TB_METAV) : (const bf16*)(ws_ + WS_VV);
        const float* gp = mg_ ? (const float*)(ws_ + TB_METAG) : (const float*)(ws_ + TB_G);
        const float* bp = mg_ ? (const float*)(ws_ + TB_METAB) : (const float*)(ws_ + TB_BETA);
        __syncthreads();
        for (int i = tid; i < ntok * 128; i += NTHREADS) { const int r = i >> 7, c = i & 127; lk[i] = bf2f(kp[(row0 + r) * GWID + h * HD + c]); lq[i] = bf2f(qp[(row0 + r) * GWID + h * HD + c]); }
        for (int i = tid; i < ntok * 64; i += NTHREADS) { const int r = i >> 6, c = i & 63; lv[i] = bf2f(vp[(row0 + r) * GWID + h * HD + 64 * dvh + c]); }
        if (tid < ntok) { lb[tid] = bp[(row0 + tid) * 4 + h]; lg[tid] = gp[(row0 + tid) * 4 + h]; }
        __syncthreads();
        for (int s = 0; s < ntok; ++s) {
            const float a = expf(lg[s]), be = lb[s];
            float kk[16], qq[16];
#pragma unroll
            for (int i4 = 0; i4 < 4; ++i4) { const f32x4 t4 = *(const LAS f32x4*)(lk + s * 128 + 16 * part + 4 * i4); kk[4 * i4] = t4.x; kk[4 * i4 + 1] = t4.y; kk[4 * i4 + 2] = t4.z; kk[4 * i4 + 3] = t4.w;
                const f32x4 u4 = *(const LAS f32x4*)(lq + s * 128 + 16 * part + 4 * i4); qq[4 * i4] = u4.x; qq[4 * i4 + 1] = u4.y; qq[4 * i4 + 2] = u4.z; qq[4 * i4 + 3] = u4.w; }
            float r = 0.f;
#pragma unroll
            for (int i = 0; i < 16; ++i) r += S[i] * kk[i];
            r += __shfl_xor(r, 1); r += __shfl_xor(r, 2); r += __shfl_xor(r, 4);
            const float vn = be * (lv[s * 64 + dvl] - a * r);
            float o = 0.f;
#pragma unroll
            for (int i = 0; i < 16; ++i) { S[i] = a * S[i] + kk[i] * vn; o += S[i] * qq[i]; }
            o += __shfl_xor(o, 1); o += __shfl_xor(o, 2); o += __shfl_xor(o, 4);
            if (!mg_ && part == 0) obuf[(row0 + s) * GWID + h * HD + 64 * dvh + dvl] = o;
        }
    }
}
__device__ __forceinline__ void p4_gdn_gate(Frame& F) {
    unsigned char* const ws_ = KWS();
    const float* obuf = (const float*)KOUT(); const bf16* zb = (const bf16*)(ws_ + WS_ZB); bf16* ycat = (bf16*)(ws_ + WS_RA); const float* gnw = KIN(8);
    const int gw = F.vcu * NWAVES + F.wave, NGW = F.G * NWAVES, lane = F.lane;
    for (int it = gw; it < T * NHEAD; it += NGW) {
        const size_t t = it >> 2; const int h = it & 3;
        const f32x2 ov = *((const f32x2*)(obuf + t * GWID + h * HD) + lane);
        const float ss = wave_sum(ov.x * ov.x + ov.y * ov.y);
        const float rms = 1.0f / sqrtf(ss * (1.0f / HD) + EPS);
        const unsigned zw = *((const unsigned*)(zb + t * GWID + h * HD) + lane);
        const float o0 = ov.x * rms * gnw[2 * lane] * siluf_(bf_lo(zw)), o1 = ov.y * rms * gnw[2 * lane + 1] * siluf_(bf_hi(zw));
        *((unsigned*)(ycat + t * D + CW + h * HD) + lane) = cvt_pk_bf16(o0, o1);
    }
}

__device__ __forceinline__ void p6_ln1_and_wexp(Frame& F) {
    unsigned char* const ws_ = KWS(); float* const out_ = KOUT(); (void)ws_; (void)out_;
    const float* x = KIN(0); const float* g1 = KIN(10); const float* b1 = KIN(11);
    const bf16* mix = (const bf16*)(ws_ + WS_MIX);
    const int gw = F.vcu * NWAVES + F.wave, NGW = F.G * NWAVES, lane = F.lane;
    for (int t = gw; t < T; t += NGW) {
        const f32x4* xr = (const f32x4*)(x + (size_t)t * D) + lane; const u32x2* mr = (const u32x2*)(mix + (size_t)t * D) + lane;
        f32x4 v[4]; float s = 0.f;
#pragma unroll
        for (int j = 0; j < 4; ++j) { const f32x4 xv = xr[64 * j]; const u32x2 m = (DBG_STAGE == 3) ? (u32x2){0u, 0u} : mr[64 * j];
            v[j] = (f32x4){ALPHA * xv.x + bf_lo(m.x), ALPHA * xv.y + bf_hi(m.x), ALPHA * xv.z + bf_lo(m.y), ALPHA * xv.w + bf_hi(m.y)}; s += (v[j].x + v[j].y) + (v[j].z + v[j].w); }
        const float mean = wave_sum(s) * (1.f / D); float s2 = 0.f;
#pragma unroll
        for (int j = 0; j < 4; ++j) { v[j] = v[j] - mean; s2 += (v[j].x * v[j].x + v[j].y * v[j].y) + (v[j].z * v[j].z + v[j].w * v[j].w); }
        const float rstd = 1.f / sqrtf(wave_sum(s2) * (1.f / D) + EPS);
        u32x2* o8 = (u32x2*)((char*)out_ + (size_t)t * 4096) + lane;
#pragma unroll
        for (int j = 0; j < 4; ++j) { const f32x4 gg = *((const f32x4*)g1 + lane + 64 * j), bb = *((const f32x4*)b1 + lane + 64 * j);
            u32x2 w; w.x = cvt_pk_bf16(v[j].x * rstd * gg.x + bb.x, v[j].y * rstd * gg.y + bb.y); w.y = cvt_pk_bf16(v[j].z * rstd * gg.z + bb.z, v[j].w * rstd * gg.w + bb.w); o8[64 * j] = w; }
    }
    LAS float* scr = (LAS float*)(F.lds + F.wave * 16640);
    bf16* Wgu = (bf16*)(ws_ + WS_X); bf16* Wd = (bf16*)(ws_ + WS_RA);
    const float* wg = KIN(14); const float* wu = KIN(15); const float* wd = KIN(16);
    for (int it = gw; it < NE * 192; it += NGW) {
        const int e = it / 192, r = it % 192;
        if (r < 64) { const int kb = r >> 2, nb = r & 3; tr_item64(wg + (size_t)e * D * EFF, EFF, 64 * kb, 64 * nb, Wgu + (size_t)e * 512 * D, D, 256 * (nb >> 1) + 64 * (nb & 1), scr, lane); }
        else if (r < 128) { const int q = r - 64, kb = q >> 2, nb = q & 3; tr_item64(wu + (size_t)e * D * EFF, EFF, 64 * kb, 64 * nb, Wgu + (size_t)e * 512 * D, D, 256 * (nb >> 1) + 128 + 64 * (nb & 1), scr, lane); }
        else { const int q = r - 128, kb = q >> 4, nb = q & 15; tr_item64(wd + (size_t)e * EFF * D, D, 64 * kb, 64 * nb, Wd + (size_t)e * D * EFF, EFF, 64 * nb, scr, lane); }
    }
}

__device__ __forceinline__ void p8_route(Frame& F) {
    unsigned char* const ws_ = KWS(); float* const out_ = KOUT(); (void)ws_; (void)out_;
    const float* logits = (const float*)(ws_ + WS_LOGITS); const float* brt = KIN(13);
    int* eidx = (int*)(ws_ + TB_EIDX); float* egate = (float*)(ws_ + TB_EGATE); int* wgcnt = (int*)(ws_ + TB_WGCNT);
    LAS int* hist = (LAS int*)(F.lds);
    const int lane = F.lane;
    if (F.tid < 256) hist[F.tid] = 0;
    __syncthreads();
    const f32x4 bias = *((const f32x4*)brt + lane);
    const int wg = F.vcu;
    for (int tt = 0; tt < 32; ++tt) {
        const int t = wg * 256 + F.wave * 32 + tt;
        const f32x4 lg = *((const f32x4*)(logits + (size_t)t * NE) + lane);
        float sc[4], sel[4];
#pragma unroll
        for (int i = 0; i < 4; ++i) { sc[i] = 1.0f / (1.0f + expf(-lg[i])); sel[i] = sc[i] + bias[i]; }
        float m1 = fmaxf(sel[0], sel[1]), m2 = fminf(sel[0], sel[1]);
        { const float n1 = fmaxf(sel[2], sel[3]), n2 = fminf(sel[2], sel[3]); const float hi = fmaxf(m1, n1); m2 = fmaxf(fminf(m1, n1), fmaxf(m2, n2)); m1 = hi; }
#pragma unroll
        for (int off = 1; off < 8; off <<= 1) { const float o1 = __shfl_xor(m1, off), o2 = __shfl_xor(m2, off); const float hi = fmaxf(m1, o1); m2 = fmaxf(fminf(m1, o1), fmaxf(m2, o2)); m1 = hi; }
        const float gs = m1 + m2; const int myg = lane >> 3; int rank = 0;
#pragma unroll
        for (int g = 0; g < 8; ++g) { const float og = __shfl(gs, 8 * g); rank += (og > gs || (og == gs && g < myg)) ? 1 : 0; }
        const bool gsel = rank < 4;
#pragma unroll
        for (int i = 0; i < 4; ++i) sel[i] = gsel ? sel[i] : -__builtin_inff();
        int myidx = 0; float mygate = 0.f; float gsum = 0.f;
#pragma unroll
        for (int k = 0; k < 8; ++k) {
            float bv = sel[0]; int bi = 4 * lane;
#pragma unroll
            for (int i = 1; i < 4; ++i) if (sel[i] > bv) { bv = sel[i]; bi = 4 * lane + i; }
#pragma unroll
            for (int off = 32; off >= 1; off >>= 1) { const float ov = __shfl_xor(bv, off); const int oi = __shfl_xor(bi, off); if (ov > bv || (ov == bv && oi < bi)) { bv = ov; bi = oi; } }
            const int sub = bi & 3; const float cand = sub == 0 ? sc[0] : (sub == 1 ? sc[1] : (sub == 2 ? sc[2] : sc[3]));
            const float gk = __shfl(cand, bi >> 2);
            if (lane == (bi >> 2)) {
#pragma unroll
                for (int i = 0; i < 4; ++i) if (i == sub) sel[i] = -__builtin_inff(); }
            gsum += gk;
            if (lane == k) { myidx = bi; mygate = gk; }
        }
        if (lane < 8) { eidx[(size_t)t * 8 + lane] = myidx; egate[(size_t)t * 8 + lane] = mygate / gsum * 2.5f; __hip_atomic_fetch_add(&hist[myidx], 1, __ATOMIC_RELAXED, __HIP_MEMORY_SCOPE_WORKGROUP); }
    }
    __syncthreads();
    if (F.tid < 256) wgcnt[wg * 256 + F.tid] = hist[F.tid];
}

__device__ __forceinline__ int excl_scan512(int v, LAS int* tmp, int tid, int& total) {
    const int lane = tid & 63, wid = tid >> 6; int x = v;
#pragma unroll
    for (int o = 1; o < 64; o <<= 1) { const int y = __shfl_up(x, o); if (lane >= o) x += y; }
    __syncthreads();
    if (lane == 63) tmp[wid] = x;
    __syncthreads();
    int base = 0, tot = 0;
#pragma unroll
    for (int w = 0; w < 8; ++w) { const int tv = tmp[w]; tot += tv; if (w < wid) base += tv; }
    total = tot;
    return base + x - v;
}
__device__ __forceinline__ void p9_dispatch(Frame& F) {
    unsigned char* const ws_ = KWS(); float* const out_ = KOUT(); (void)ws_; (void)out_;
    const int* wgcnt = (const int*)(ws_ + TB_WGCNT); const int* eidx = (const int*)(ws_ + TB_EIDX); const float* egate = (const float*)(ws_ + TB_EGATE);
    int* yrow = (int*)(ws_ + TB_YROW); unsigned* stok = (unsigned*)(ws_ + TB_STOK); float* sgate = (float*)(ws_ + TB_SGATE); int* gtab = (int*)(ws_ + TB_GTAB);
    LAS int* L = (LAS int*)(F.lds);
    LAS int* s_base = L, *s_tot0 = L + 260, *s_yb0 = L + 520, *s_yb1 = L + 780, *s_my = L + 1040, *s_cnt = L + 1300, *tmp = L + 1560;
    const int tid = F.tid, wg = F.vcu, e = tid;
    int t0 = 0, t1 = 0, my = 0;
    if (tid < 256) {
        for (int w = 0; w < 256; ++w) { const int c = wgcnt[w * 256 + e]; if (w < 128) t0 += c; else t1 += c; if (w < wg) my += c; }
        s_cnt[e] = 0; s_my[e] = my; s_tot0[e] = t0;
    }
    const int n = t0 + t1;
    int tot;
    const int base = excl_scan512(tid < 256 ? n : 0, tmp, tid, tot);
    const int yb0 = excl_scan512(tid < 256 ? t0 : 0, tmp, tid, tot);
    const int yb1 = excl_scan512(tid < 256 ? t1 : 0, tmp, tid, tot);
    int nt1, nt20, nt21;
    const int ts1 = excl_scan512(tid < 256 ? (n + 255) / 256 : 0, tmp, tid, nt1);
    const int ts20 = excl_scan512(tid < 256 ? (t0 + 255) / 256 : 0, tmp, tid, nt20);
    const int ts21 = excl_scan512(tid < 256 ? (t1 + 255) / 256 : 0, tmp, tid, nt21);
    if (tid < 256) { s_base[e] = base; s_yb0[e] = yb0; s_yb1[e] = yb1; }
    if (wg == 0) {
        if (tid < 256) { gtab[GT_BASE * 260 + e] = base; gtab[GT_N * 260 + e] = n; gtab[GT_TOT0 * 260 + e] = t0; gtab[GT_YB0 * 260 + e] = yb0; gtab[GT_YB1 * 260 + e] = yb1;
            gtab[GT_TS1 * 260 + e] = ts1; gtab[GT_TS20 * 260 + e] = ts20; gtab[GT_TS21 * 260 + e] = ts21; }
        if (tid == 0) { gtab[GT_TS1 * 260 + 256] = nt1; gtab[GT_TS20 * 260 + 256] = nt20; gtab[GT_TS21 * 260 + 256] = nt21; }
    }
    __syncthreads();
    const int half = wg >= 128 ? 1 : 0;
    {
        const int t = wg * 256 + (tid >> 1), k0 = (tid & 1) * 4;
#pragma unroll
        for (int kk = 0; kk < 4; ++kk) { const int k = k0 + kk; const int ee = eidx[(size_t)t * 8 + k]; const float gt = egate[(size_t)t * 8 + k];
            const int r = __hip_atomic_fetch_add(&s_cnt[ee], 1, __ATOMIC_RELAXED, __HIP_MEMORY_SCOPE_WORKGROUP);
            const int within = s_my[ee] + r;
            const int slot = s_base[ee] + within;
            stok[slot] = (unsigned)t * 4096u; sgate[slot] = gt;
            yrow[(size_t)t * 8 + k] = (half ? s_yb1[ee] : s_yb0[ee]) + within - (half ? s_tot0[ee] : 0);
        }
    }
    if (tid < 256) { const int t = wg * 256 + tid; stok[NSR + t] = (unsigned)t * 4096u; sgate[NSR + t] = 1.0f; }
    if (wg == 0 && tid < 256) { stok[NSLOT + tid] = 0u; sgate[NSLOT + tid] = 0.f; }
}

__device__ __forceinline__ int find_expert(const LAS int* ts, int tile) {
    int lo = 0, hi = 256;
#pragma unroll 1
    while (hi - lo > 1) { const int mid = (lo + hi) >> 1; if (ts[mid] <= tile) lo = mid; else hi = mid; }
    return lo;
}
struct Gemm1Sched {
    const LAS int* ts; const LAS int* base; const LAS int* nn; const LAS unsigned* tab; int NT1, G, c;
    const char* h1; const char* Wgu; const char* Wsgu; char* Hbuf;
    __device__ __forceinline__ bool next(int i, g8::UnitG& u) const {
        const int L = i * G + c; const int tile = L >> 1, pn = L & 1;
        if (tile >= NT1 + T / 256) return false;
        int e, r, slot0, valid; const char* B;
        if (tile < NT1) { e = find_expert(ts, tile); r = tile - ts[e]; slot0 = base[e] + 256 * r; valid = nn[e] - 256 * r; valid = valid > 256 ? 256 : valid; B = Wgu + ((size_t)(e * 2 + pn) * 256) * D * 2; }
        else { r = tile - NT1; slot0 = NSR + 256 * r; valid = 256; B = Wsgu + ((size_t)pn * 256) * D * 2; }
        u.A = h1; u.B = B; u.O = Hbuf + (size_t)slot0 * (EFF * 2) + pn * 256; u.ldo = EFF * 2; u.p0 = slot0; u.p1 = valid; u.p2 = pn; return true;
    }
    static constexpr bool GATHER = true;
    __device__ __forceinline__ int pitch() const { return 0; }
    __device__ __forceinline__ unsigned aoff(int ui, int row, int cb) const { return tab[ui * 256 + row] + (unsigned)cb; }
};
struct Gemm2Sched {
    const LAS int* ts; const LAS int* base; const LAS int* cntv; const LAS int* yb; const LAS int* tot0; int NT2, G, c, half;
    const char* Hbuf; const char* Wd; const char* Wsd; char* Y; char* out;
    __device__ __forceinline__ bool next(int i, g8::UnitG& u) const {
        const int L = i * G + c; const int tile = L >> 2, pn = L & 3;
        if (tile >= NT2 + HALF_T / 256) return false;
        if (tile < NT2) { const int e = find_expert(ts, tile), r = tile - ts[e]; const int slot0 = base[e] + (half ? tot0[e] : 0) + 256 * r; int valid = cntv[e] - 256 * r; valid = valid > 256 ? 256 : valid;
            u.A = Hbuf + (size_t)slot0 * (EFF * 2); u.B = Wd + ((size_t)e * D + 256 * pn) * EFF * 2; u.O = Y + (size_t)(yb[e] + 256 * r) * 2048 + pn * 512; u.ldo = 2048; u.p0 = slot0; u.p1 = valid; u.p2 = 0; }
        else { const int r = tile - NT2; const int tok0 = half * HALF_T + 256 * r; const int slot0 = NSR + tok0;
            u.A = Hbuf + (size_t)slot0 * (EFF * 2); u.B = Wsd + ((size_t)256 * pn) * EFF * 2; u.O = out + (size_t)tok0 * 4096 + 2048 + pn * 512; u.ldo = 4096; u.p0 = slot0; u.p1 = 256; u.p2 = 1; }
        return true;
    }
    static constexpr bool GATHER = false;
    __device__ __forceinline__ int pitch() const { return EFF * 2; }
    __device__ __forceinline__ unsigned aoff(int, int row, int cb) const { return (unsigned)(row * EFF * 2 + cb); }
};

__device__ __forceinline__ void p_combine(Frame& F, int half) {
    unsigned char* const ws_ = KWS(); float* const out_ = KOUT();
    const float* g2 = KIN(20); const float* b2 = KIN(21);
    const int* yrow = (const int*)(ws_ + TB_YROW); const char* Y = (const char*)(ws_ + WS_X);
    const int gw = F.vcu * NWAVES + F.wave, NGW = F.G * NWAVES, lane = F.lane;
#pragma unroll 1
    for (int tt0 = gw; tt0 < HALF_T; tt0 += NGW) {
        float acc[1][16]; char* orow[1];
#pragma unroll
        for (int u = 0; u < 1; ++u) {
            const int t = half * HALF_T + tt0 + u;
            orow[u] = (char*)out_ + (size_t)t * 4096;
            const u32x4 h0 = *(const u32x4*)(orow[u] + 32 * lane), h1 = *(const u32x4*)(orow[u] + 32 * lane + 16);
            const u32x4 s0 = *(const u32x4*)(orow[u] + 2048 + 32 * lane), s1 = *(const u32x4*)(orow[u] + 2048 + 32 * lane + 16);
            const int myrow = yrow[(size_t)t * 8 + (lane & 7)];
            u32x4 y0[8], y1[8];
#pragma unroll
            for (int k = 0; k < 8; ++k) { const int yr = __shfl(myrow, k); const char* yp = Y + (size_t)yr * 2048 + 32 * lane; y0[k] = *(const u32x4*)(yp); y1[k] = *(const u32x4*)(yp + 16); }
            float t8[8];
            unpack8(h0, t8);
#pragma unroll
            for (int j = 0; j < 8; ++j) acc[u][j] = ALPHA * t8[j];
            unpack8(h1, t8);
#pragma unroll
            for (int j = 0; j < 8; ++j) acc[u][8 + j] = ALPHA * t8[j];
            unpack8(s0, t8);
#pragma unroll
            for (int j = 0; j < 8; ++j) acc[u][j] += t8[j];
            unpack8(s1, t8);
#pragma unroll
            for (int j = 0; j < 8; ++j) acc[u][8 + j] += t8[j];
#pragma unroll
            for (int k = 0; k < 8; ++k) { unpack8(y0[k], t8);
#pragma unroll
                for (int j = 0; j < 8; ++j) acc[u][j] += t8[j];
                unpack8(y1[k], t8);
#pragma unroll
                for (int j = 0; j < 8; ++j) acc[u][8 + j] += t8[j]; }
        }
#pragma unroll
        for (int u = 0; u < 1; ++u) {
            float s = 0.f;
#pragma unroll
            for (int j = 0; j < 16; ++j) s += acc[u][j];
            const float mean = wave_sum(s) * (1.f / D); float s2 = 0.f;
#pragma unroll
            for (int j = 0; j < 16; ++j) { acc[u][j] -= mean; s2 += acc[u][j] * acc[u][j]; }
            const float rstd = 1.f / sqrtf(wave_sum(s2) * (1.f / D) + EPS);
            float pert = 0.f;
            if (GDN_PROBE) { const unsigned code = *((const unsigned*)(ws_ + WS_CTL) + CW_DBG); if (code) pert = 0.1f * (float)(1 + __builtin_ctz(code)); }
#pragma unroll
            for (int q = 0; q < 4; ++q) { const f32x4 gg = *((const f32x4*)(g2 + 16 * lane) + q), bb = *((const f32x4*)(b2 + 16 * lane) + q);
                *((f32x4*)(orow[u] + 64 * lane) + q) = (f32x4){acc[u][4 * q] * rstd * gg.x + bb.x + pert, acc[u][4 * q + 1] * rstd * gg.y + bb.y + pert, acc[u][4 * q + 2] * rstd * gg.z + bb.z + pert, acc[u][4 * q + 3] * rstd * gg.w + bb.w + pert}; }
        }
    }
}

__device__ __forceinline__ void load_gtabs(Frame& F, LAS int* dst) {
    unsigned char* const ws_ = KWS();
    const int* gtab = (const int*)(ws_ + TB_GTAB);
    for (int i = F.tid; i < 8 * 260; i += NTHREADS) dst[i] = gtab[i];
    __syncthreads();
}

__global__ void __launch_bounds__(NTHREADS, 2) hymba_fwd(Args args) {
    extern __shared__ __attribute__((aligned(16))) unsigned char lds_raw[];
#define MKFRAME() Frame F; { F.lds = (LAS unsigned char*)lds_raw; int t_ = threadIdx.x; asm volatile("" : "+v"(t_)); F.tid = t_; F.lane = t_ & 63; F.wave = __builtin_amdgcn_readfirstlane(t_ >> 6); \
        F.G = gridDim.x; const int bx = blockIdx.x; F.vcu = (F.G % 8 == 0) ? (bx % 8) * (F.G / 8) + bx / 8 : bx; }
    volatile LAS unsigned* MISC = (volatile LAS unsigned*)((LAS unsigned char*)lds_raw + LDS_MISC);
    if (threadIdx.x < 32) MISC[threadIdx.x] = 0u;
    __syncthreads();
    unsigned* ctl = (unsigned*)(KWS() + WS_CTL);
    XcdBarrier bar; bar.bar = ctl + CW_BAR; bar.x = 0; bar.st = nullptr;
    if (MK_LAUNCHES == 1) bar = xcd_barrier_post(ctl + CW_BAR, MISC + 8);
    const int lo = karg32<192>(), hi = karg32<196>();
#ifndef PH_MASK
#define PH_MASK 0x7fff
#endif
#ifndef DUP_MASK
#define DUP_MASK 0
#endif
#define IN(k) ((((PH_MASK) >> (k)) & 1) && lo <= (k) && (k) < hi)
#define DUPN(k) ((((DUP_MASK) >> (k)) & 1) ? 2 : 1)
#define SEAM(k) do { if (IN(k) && IN((k) + 1)) xcd_barrier(bar); } while (0)

    if (IN(0)) for (int rep = 0; rep < DUPN(0); ++rep) { MKFRAME(); p0_prologue(F); __syncthreads(); } SEAM(0);
    if (IN(1)) for (int rep = 0; rep < DUPN(1); ++rep) {
        MKFRAME(); unsigned char* const ws_ = KWS();
        g8::DenseSched S; S.init(ws_ + WS_RA, ws_ + W_WINT, ws_ + WS_RB, T, NPJ, D, NPJ * 2, 2, F.G, (int)blockIdx.x);
        g8::EpiBf16 E; g8::gemm_core<g8::EpiBf16, g8::DenseSched>(F.lds + LDS_STAGE, D, S, E);
    } SEAM(1);
    if (IN(2)) for (int rep = 0; rep < DUPN(2); ++rep) { MKFRAME(); p2_prep(F); } SEAM(2);
#if GDN_RECURRENT
    if (IN(3)) for (int rep = 0; rep < DUPN(3); ++rep) { { MKFRAME(); p3_gdn_recurrent(F); } __syncthreads(); if (GDN_PROBE) { MKFRAME(); p3_gdn_local(F); } } SEAM(3);
    if (IN(4)) for (int rep = 0; rep < DUPN(4); ++rep) { { MKFRAME(); p4_gdn_gate(F); } __syncthreads(); if (GDN_PROBE) { MKFRAME(); p4_gdn_scan(F); } } SEAM(4);
#else
    if (IN(3)) { MKFRAME(); p3_gdn_local(F); } SEAM(3);
    if (IN(4)) { MKFRAME(); p4_gdn_scan(F); } SEAM(4);
#endif
    if (IN(5)) for (int rep = 0; rep < DUPN(5); ++rep) {
        MKFRAME(); unsigned char* const ws_ = KWS();
        g8::DenseSched S; S.init(ws_ + WS_RA, ws_ + W_WOUTT, ws_ + WS_MIX, T, D, D, D * 2, 2, F.G, (int)blockIdx.x);
        g8::EpiBf16 E; g8::gemm_core<g8::EpiBf16, g8::DenseSched>(F.lds + LDS_STAGE, D, S, E);
    } SEAM(5);
    if (IN(6)) for (int rep = 0; rep < DUPN(6); ++rep) { MKFRAME(); p6_ln1_and_wexp(F); __syncthreads(); } SEAM(6);
    if (IN(7)) for (int rep = 0; rep < DUPN(7); ++rep) {
        MKFRAME(); unsigned char* const ws_ = KWS(); float* const out_ = KOUT();
        struct RSched : g8::DenseSched {
            __device__ __forceinline__ bool next(int i, g8::UnitG& u) const { if (!g8::DenseSched::next(i, u)) return false; u.A = A + (size_t)u.p0 * 256 * 4096; return true; }
            __device__ __forceinline__ int pitch() const { return 4096; }
            __device__ __forceinline__ unsigned aoff(int, int row, int cb) const { return (unsigned)(row * 4096 + cb); }
        } S; S.init(out_, ws_ + W_WRT, ws_ + WS_LOGITS, T, NE, D, NE * 4, 4, F.G, (int)blockIdx.x);
        g8::EpiF32 E; g8::gemm_core<g8::EpiF32, RSched>(F.lds + LDS_STAGE, D, S, E);
    } SEAM(7);
    if (IN(8)) for (int rep = 0; rep < DUPN(8); ++rep) { MKFRAME(); p8_route(F); __syncthreads(); } SEAM(8);
    if (IN(9)) { MKFRAME(); p9_dispatch(F); } SEAM(9);
    if (IN(10)) for (int rep = 0; rep < DUPN(10); ++rep) {
        MKFRAME(); unsigned char* const ws_ = KWS(); float* const out_ = KOUT();
        LAS int* tb = (LAS int*)(F.lds + LDS_TS); load_gtabs(F, tb);
        Gemm1Sched S; S.ts = tb + GT_TS1 * 260; S.base = tb + GT_BASE * 260; S.nn = tb + GT_N * 260; S.tab = (const LAS unsigned*)(F.lds + LDS_AUX); S.NT1 = tb[GT_TS1 * 260 + 256]; S.G = F.G; S.c = F.vcu;
        S.h1 = (const char*)out_; S.Wgu = (const char*)(ws_ + WS_X); S.Wsgu = (const char*)(ws_ + W_WSGU); S.Hbuf = (char*)(ws_ + WS_HBUF);
        {
            const unsigned* stok = (const unsigned*)(ws_ + TB_STOK); LAS unsigned* tab = (LAS unsigned*)(F.lds + LDS_AUX);
            for (int ui = 0; ui < 20; ++ui) { g8::UnitG u; if (!S.next(ui, u)) break;
                if (F.tid < 256) tab[ui * 256 + F.tid] = stok[u.p0 + (F.tid < u.p1 ? F.tid : 0)]; }
            __syncthreads();
        }
        g8::EpiH E; g8::gemm_core<g8::EpiH, Gemm1Sched>(F.lds + LDS_STAGE, D, S, E);
    } SEAM(10);
#define MOE_HALF(PH, HALFV) \
    if (IN(PH)) for (int rep = 0; rep < DUPN(PH); ++rep) { \
        MKFRAME(); unsigned char* const ws_ = KWS(); float* const out_ = KOUT(); \
        LAS int* tb = (LAS int*)(F.lds + LDS_TS); load_gtabs(F, tb); \
        LAS int* cv = tb + 8 * 260; \
        if (F.tid < 256) cv[F.tid] = (HALFV) ? (tb[GT_N * 260 + F.tid] - tb[GT_TOT0 * 260 + F.tid]) : tb[GT_TOT0 * 260 + F.tid]; \
        __syncthreads(); \
        Gemm2Sched S; S.ts = tb + ((HALFV) ? GT_TS21 : GT_TS20) * 260; S.base = tb + GT_BASE * 260; S.cntv = cv; S.yb = tb + ((HALFV) ? GT_YB1 : GT_YB0) * 260; S.tot0 = tb + GT_TOT0 * 260; \
        S.NT2 = tb[((HALFV) ? GT_TS21 : GT_TS20) * 260 + 256]; S.G = F.G; S.c = F.vcu; S.half = (HALFV); \
        S.Hbuf = (const char*)(ws_ + WS_HBUF); S.Wd = (const char*)(ws_ + WS_RA); S.Wsd = (const char*)(ws_ + W_WSD); S.Y = (char*)(ws_ + WS_X); S.out = (char*)out_; \
        g8::EpiY E; E.sgate = (const float*)(ws_ + TB_SGATE); \
        g8::gemm_core<g8::EpiY, Gemm2Sched>(F.lds + LDS_STAGE, EFF, S, E); \
    } SEAM(PH); \
    if (IN((PH) + 1)) { MKFRAME(); p_combine(F, (HALFV)); } SEAM((PH) + 1);
    MOE_HALF(11, 0)
    MOE_HALF(13, 1)
#undef IN
#undef SEAM
}

extern "C" void kernel_launch(void* const* d_in, const int* in_sizes, int n_in, void* d_out, int out_size, void* d_ws, size_t ws_size, hipStream_t stream) {
    static int grid = 0;
    if (grid == 0) {
        if (n_in != 22 || out_size != T * D || ws_size < WS_END) { fprintf(stderr, "kernel_launch: unexpected shapes (n_in %d out %d ws %zu need %zu)\n", n_in, out_size, ws_size, (size_t)WS_END); grid = -1; return; }
        int dev = 0, cus = 0, per_cu = 0;
        if (hipGetDevice(&dev) != hipSuccess || hipDeviceGetAttribute(&cus, hipDeviceAttributeMultiprocessorCount, dev) != hipSuccess) { grid = -1; return; }
        if (hipFuncSetAttribute((const void*)hymba_fwd, hipFuncAttributeMaxDynamicSharedMemorySize, LDS_BYTES) != hipSuccess) { fprintf(stderr, "kernel_launch: hipFuncSetAttribute failed\n"); grid = -1; return; }
        if (hipOccupancyMaxActiveBlocksPerMultiprocessor(&per_cu, (const void*)hymba_fwd, NTHREADS, LDS_BYTES) != hipSuccess || per_cu < 1) fprintf(stderr, "kernel_launch: occupancy query says %d\n", per_cu);
        (void)hipGetLastError();
        grid = cus;
        if (grid != 256) fprintf(stderr, "kernel_launch: %d CUs (built for 256)\n", grid);
    }
    if (grid < 0) return;
    (void)hipMemsetAsync((char*)d_ws + WS_CTL, 0, CTL_BYTES, stream);
    Args a{};
    for (int i = 0; i < 22; ++i) a.in[i] = (const float*)d_in[i];
    a.out = (float*)d_out; a.ws = (unsigned char*)d_ws; a.li = 0; a.pad = 0;
#if MK_LAUNCHES == 1
    a.ph_lo = 0; a.ph_hi = NPHASE;
    hipLaunchKernelGGL(hymba_fwd, dim3(grid), dim3(NTHREADS), LDS_BYTES, stream, a);
#else
    for (int p = 0; p < NPHASE; ++p) { if ((DBG_STAGE == 1 || DBG_STAGE == 5) && p >= 7 && p != 12 && p != 14) continue; if (DBG_STAGE == 3 && p != 6 && p != 12 && p != 14) continue; if (DBG_STAGE == 4 && p != 0 && p != 1 && p != 2 && p != 5 && p != 6 && p != 12 && p != 14) continue; a.ph_lo = p; a.ph_hi = p + 1; a.li = p; hipLaunchKernelGGL(hymba_fwd, dim3(grid), dim3(NTHREADS), LDS_BYTES, stream, a); }
#endif
}
```

```cpp
#include <hip/hip_runtime.h>
#include <cstdio>
#include <cstdint>

#ifndef DBG_STAGE
#define DBG_STAGE 0
#endif
#ifndef GDN_PROBE
#define GDN_PROBE 0
#endif
constexpr int CW_DBG = 64;
#ifndef MK_LAUNCHES
#define MK_LAUNCHES 1
#endif

#define LAS __attribute__((address_space(3)))
#define GAS __attribute__((address_space(1)))
typedef unsigned short bf16;
typedef short bf16x8 __attribute__((ext_vector_type(8)));
typedef float f32x4 __attribute__((ext_vector_type(4)));
typedef float f32x2 __attribute__((ext_vector_type(2)));
typedef unsigned u32x4 __attribute__((ext_vector_type(4)));
typedef unsigned u32x2 __attribute__((ext_vector_type(2)));

constexpr int BATCH = 32, SEQ = 2048, D = 1024, T = BATCH * SEQ;
constexpr int NMETA = 16, CW = 512, GWID = 512, NHEAD = 4, HD = 128, INC = 3592, NPJ = 3584;
constexpr int NE = 256, TOPK = 8, EFF = 256;
constexpr float ALPHA = 1.189207115002721f, EPS = 1e-5f;
constexpr int NPHASE = 13;
constexpr int NTHREADS = 512, NWAVES = 8;
constexpr int NSR = T * TOPK;
constexpr int NSLOT = NSR + T;
constexpr int HALF_T = T / 2;

constexpr size_t MiB = 1u << 20;
constexpr size_t WS_CTL = 0, CTL_BYTES = 1 * MiB;
constexpr size_t WS_TAB = 1 * MiB;
constexpr size_t TB_WGCNT = WS_TAB;
constexpr size_t TB_GTAB = TB_WGCNT + 256 * 256 * 4;
constexpr size_t TB_EIDX = TB_GTAB + 16 * 260 * 4 + 1536;
constexpr size_t TB_EGATE = TB_EIDX + (size_t)T * 8 * 4;
constexpr size_t TB_YROW = TB_EGATE + (size_t)T * 8 * 4;
constexpr size_t TB_STOK = TB_YROW + (size_t)T * 8 * 4;
constexpr size_t TB_SGATE = TB_STOK + (size_t)(NSLOT + 256) * 4;
constexpr size_t TB_BD = TB_SGATE + (size_t)(NSLOT + 256) * 4;
constexpr size_t TB_BETA = TB_BD + (size_t)T * 8 * 4;
constexpr size_t TB_G = TB_BETA + (size_t)T * 4 * 4;
constexpr size_t TB_PROJM = TB_G + (size_t)T * 4 * 4;
constexpr size_t TB_METAQ = TB_PROJM + 16 * INC * 4;
constexpr size_t TB_METAK = TB_METAQ + 64 * 512 * 2;
constexpr size_t TB_METAV = TB_METAK + 64 * 512 * 2;
constexpr size_t TB_METAB = TB_METAV + 64 * 512 * 2;
constexpr size_t TB_METAG = TB_METAB + 64 * 4 * 4;
constexpr size_t TB_END = TB_METAG + 64 * 4 * 4;
constexpr size_t WS_WSM = 17 * MiB;
constexpr size_t W_WINT = WS_WSM;
constexpr size_t W_WOUTT = W_WINT + (size_t)NPJ * D * 2;
constexpr size_t W_WRT = W_WOUTT + (size_t)D * D * 2;
constexpr size_t W_WSGU = W_WRT + (size_t)NE * D * 2;
constexpr size_t W_WSD = W_WSGU + (size_t)512 * D * 2;
constexpr size_t W_END = W_WSD + (size_t)D * EFF * 2;
constexpr size_t WS_RA = 29 * MiB;
constexpr size_t WS_RB = 157 * MiB;
constexpr size_t WS_HBUF = 157 * MiB;
constexpr size_t WS_X = 446 * MiB;
constexpr size_t WS_QN = 605 * MiB, WS_KN = 669 * MiB, WS_VV = 733 * MiB;
constexpr size_t WS_ZB = 797 * MiB;
constexpr size_t WS_MIX = 733 * MiB;
constexpr size_t WS_LOGITS = 861 * MiB;
constexpr size_t WS_END = 958 * MiB;
constexpr int GBLK = 81920;
constexpr int GB_UT = 0, GB_WP = 18432, GB_QD = 35840, GB_KDT = 53248, GB_ATT = 71680, GB_EG = 80896;
static_assert(TB_END <= WS_WSM && W_END <= WS_RA, "ws map");
static_assert(WS_RB + (size_t)T * NPJ * 2 <= WS_QN && WS_RB + (size_t)4100 * GBLK <= WS_QN, "ws map");
static_assert(WS_HBUF + (size_t)(NSLOT + 256) * 512 <= WS_X && WS_X + (size_t)(NE * 512) * D * 2 <= WS_MIX, "ws map");
static_assert(WS_X + (size_t)NSR * 1024 <= WS_END, "ws map");

constexpr int CW_BAR = 4096;

constexpr int LDS_STAGE = 0;
constexpr int LDS_AUX = 131072;
constexpr int LDS_TS = LDS_AUX + 20480;
constexpr int LDS_MISC = LDS_TS + 9344;
constexpr int LDS_BYTES = LDS_MISC + 128;
static_assert(LDS_BYTES <= 163840, "LDS");

typedef __bf16 bf16x2_t __attribute__((ext_vector_type(2)));
__device__ __forceinline__ unsigned cvt_pk_bf16(float lo, float hi) { const f32x2 v = {lo, hi}; return __builtin_bit_cast(unsigned, __builtin_convertvector(v, bf16x2_t)); }
__device__ __forceinline__ float bf_lo(unsigned w) { return __uint_as_float(w << 16); }
__device__ __forceinline__ float bf_hi(unsigned w) { return __uint_as_float(w & 0xffff0000u); }
__device__ __forceinline__ float bf2f(bf16 b) { return __uint_as_float(((unsigned)b) << 16); }
__device__ __forceinline__ void unpack8(const u32x4 w, float (&o)[8]) { o[0] = bf_lo(w.x); o[1] = bf_hi(w.x); o[2] = bf_lo(w.y); o[3] = bf_hi(w.y); o[4] = bf_lo(w.z); o[5] = bf_hi(w.z); o[6] = bf_lo(w.w); o[7] = bf_hi(w.w); }
__device__ __forceinline__ u32x4 pack8(const float (&v)[8]) { u32x4 w; w.x = cvt_pk_bf16(v[0], v[1]); w.y = cvt_pk_bf16(v[2], v[3]); w.z = cvt_pk_bf16(v[4], v[5]); w.w = cvt_pk_bf16(v[6], v[7]); return w; }
__device__ __forceinline__ float wave_sum(float v) {
#pragma unroll
    for (int o = 1; o < 64; o <<= 1) v += __shfl_xor(v, o);
    return v;
}
__device__ __forceinline__ float fast_exp(float x) { return __builtin_amdgcn_exp2f(x * 1.4426950408889634f); }
__device__ __forceinline__ float sigmoidf_(float x) { return __builtin_amdgcn_rcpf(1.0f + fast_exp(-x)); }
__device__ __forceinline__ float siluf_(float x) { return x * sigmoidf_(x); }
#define LDS_WAIT() asm volatile("s_waitcnt lgkmcnt(0)" ::: "memory")
#define VM_WAIT() asm volatile("s_waitcnt vmcnt(0)" ::: "memory")

#define XB_TMO      128
#define XB_XCNT(j)  (256  + 64 * (j))
#define XB_XSUB(j)  (1280 + 64 * (j))
#define XB_XGEN(j)  (2304 + 64 * (j))
#define XB_TOP      3328
#define XB_TOPGEN   3392
#define XCD_BAR_WORDS 3456
#define XB_SPIN_CAP (1u << 22)
__device__ __forceinline__ unsigned xb_ld(unsigned* p)              { return __hip_atomic_load(p, __ATOMIC_RELAXED, __HIP_MEMORY_SCOPE_AGENT); }
__device__ __forceinline__ unsigned xb_add(unsigned* p, unsigned v) { return __hip_atomic_fetch_add(p, v, __ATOMIC_RELAXED, __HIP_MEMORY_SCOPE_AGENT); }
__device__ __forceinline__ unsigned xb_xcc_id() { return (unsigned)__builtin_amdgcn_s_getreg((3 << 11) | 20) & 0xFu; }
#define XB_SPIN(cond, bar) do { unsigned _sp = 0; while (cond) { __builtin_amdgcn_s_sleep(1); \
    if ((++_sp & 255u) == 0u) { if (xb_ld(&(bar)[XB_TMO])) break; if (_sp > XB_SPIN_CAP) { atomicAdd(&(bar)[XB_TMO], 1u); break; } } } } while (0)
struct XcdBarrier { unsigned* bar; unsigned x; volatile LAS unsigned* st; };
__device__ __forceinline__ XcdBarrier xcd_barrier_post(unsigned* bar, volatile LAS unsigned* st) {
    XcdBarrier b; b.bar = bar; b.x = xb_xcc_id(); b.st = st;
    if (threadIdx.x == 0) (void)xb_add(&bar[XB_XCNT(b.x)], 1u);
    return b;
}
__device__ __forceinline__ void xcd_barrier_complete(unsigned* bar, unsigned x, unsigned& nloc, unsigned& nx) {
    const unsigned G = gridDim.x * gridDim.y * gridDim.z;
    unsigned sum, cnt, mine, sp = 0u;
    for (;;) {
        sum = 0u; cnt = 0u; mine = 0u;
#pragma unroll
        for (unsigned j = 0; j < 16; ++j) { const unsigned c = xb_ld(&bar[XB_XCNT(j)]); sum += c; cnt += (c > 0u) ? 1u : 0u; mine = (j == x) ? c : mine; }
        if (sum == G) break;
        __builtin_amdgcn_s_sleep(1);
        if ((++sp & 255u) == 0u) { if (xb_ld(&bar[XB_TMO])) break; if (sp > XB_SPIN_CAP) { atomicAdd(&bar[XB_TMO], 1u); break; } }
    }
    nloc = mine > 0u ? mine : 1u; nx = cnt > 0u ? cnt : 1u;
}
__device__ __forceinline__ void xcd_barrier(const XcdBarrier& b) {
    asm volatile("s_waitcnt vmcnt(0)" ::: "memory");
    __syncthreads();
    if (threadIdx.x == 0) {
        unsigned* bar = b.bar;
        __builtin_amdgcn_s_waitcnt(0);
        unsigned nloc = b.st[0], nx = b.st[1];
        if (nloc == 0u) { xcd_barrier_complete(bar, b.x, nloc, nx); b.st[0] = nloc; b.st[1] = nx; }
        const unsigned old = xb_add(&bar[XB_XSUB(b.x)], 1u);
        const unsigned gen = old / nloc;
        if (old + 1u == (gen + 1u) * nloc) {
            __builtin_amdgcn_fence(__ATOMIC_RELEASE, "agent");
            asm volatile("s_waitcnt vmcnt(0)" ::: "memory");
            const unsigned og = xb_add(&bar[XB_TOP], 1u);
            const unsigned tg = og / nx;
            if (og + 1u == (tg + 1u) * nx) xb_add(&bar[XB_TOPGEN], 1u);
            else XB_SPIN(xb_ld(&bar[XB_TOPGEN]) == tg, bar);
            __builtin_amdgcn_fence(__ATOMIC_ACQUIRE, "agent");
            xb_add(&bar[XB_XGEN(b.x)], 1u);
            asm volatile("s_waitcnt vmcnt(0)" ::: "memory");
        } else {
            XB_SPIN(xb_ld(&bar[XB_XGEN(b.x)]) == gen, bar);
            __builtin_amdgcn_fence(__ATOMIC_ACQUIRE, "agent");
            asm volatile("s_waitcnt vmcnt(0)" ::: "memory");
        }
    }
    __syncthreads();
}

namespace g8 {
constexpr int BM = 256, BK = 64, HALF = 128, HTB = HALF * BK * 2, STAGE_BYTES = 8 * HTB, NXCD = 8, WGM = 8;
__host__ __device__ __forceinline__ int lds_byte(int r, int c) { const int st = (r >> 4) * 2 + (c >> 5), rr = r & 15, cc = c & 31, ob = rr * 64 + cc * 2; return st * 1024 + (ob ^ (((ob >> 9) & 1) << 5)); }
__host__ __device__ __forceinline__ void stage_rc(int b, int& R, int& C) { const int st = b / 1024, sb = b % 1024, swz = sb ^ (((sb >> 9) & 1) << 5); R = (st >> 1) * 16 + swz / 64; C = (st & 1) * 32 + (swz % 64) / 2; }
__host__ __device__ __forceinline__ int perm32(int rho) { const int n = rho >> 4, i = rho & 15; return 8 * (i >> 2) + 4 * n + (i & 3); }

struct UnitG { const char* A; const char* B; char* O; int ldo; int p0, p1, p2; };

template <class Epi, class Sched>
__device__ __forceinline__ void gemm_core(LAS unsigned char* lds, const int K, const Sched& S, const Epi& E) {
    int tid = threadIdx.x; asm volatile("" : "+v"(tid));
    const int wid = __builtin_amdgcn_readfirstlane(tid >> 6), lane = tid & 63, wr = wid >> 2, wc = wid & 3, fr = lane & 15, fq = lane >> 4;
    const int nt = K / BK;
    int R0, C0; stage_rc(tid * 16, R0, C0);
    unsigned voffB[2];
#pragma unroll
    for (int i = 0; i < 2; ++i) { const int R = R0 + 64 * i;
        const int Rb = Epi::PMODE == 1 ? ((R & ~31) + perm32(R & 31)) : (Epi::PMODE == 2 ? (64 * (R >> 5) + 16 * ((R >> 2) & 3) + 4 * ((R >> 4) & 1) + (R & 3)) : R);
        voffB[i] = (unsigned)(Rb * K + C0) * 2u; }
    const size_t kstep = (size_t)(BK * 2);
    const size_t hstep = Epi::PMODE == 2 ? (size_t)8 * K * 2 : (size_t)HALF * K * 2;
    const unsigned ldsw = (unsigned)wid * 1024u;
    const int aoff = lds_byte(wr * 64 + fr, fq * 8), boff = lds_byte(wc * 32 + fr, fq * 8);
#define G8_SA(b, h) (((b) * 2 + (h)) * HTB)
#define G8_SB(b, h) ((4 + (b) * 2 + (h)) * HTB)
#define G8_STAGE(bufoff, gbase, voff) do { _Pragma("unroll") for (int _i = 0; _i < 2; ++_i) \
        __builtin_amdgcn_global_load_lds((const unsigned*)((const char*)(gbase) + (voff)[_i]), (LAS unsigned*)(lds + (bufoff) + ldsw + _i * 8192), 16, 0, 0); } while (0)
#define G8_STAGE_A(bufoff, gbase, h) do { if constexpr (Sched::GATHER) { G8_STAGE(bufoff, gbase, ao[h]); } else { G8_STAGE(bufoff, (gbase) + (h) * hstepA, ao[0]); } } while (0)
#define G8_LDA(dst, b, h) do { _Pragma("unroll") for (int m = 0; m < 4; ++m) _Pragma("unroll") for (int k = 0; k < 2; ++k) dst[m][k] = *(const LAS bf16x8*)(lds + G8_SA(b, h) + aoff + m * 2048 + k * 1024); } while (0)
#define G8_LDB(dst, b, h) do { _Pragma("unroll") for (int n = 0; n < 2; ++n) _Pragma("unroll") for (int k = 0; k < 2; ++k) dst[n][k] = *(const LAS bf16x8*)(lds + G8_SB(b, h) + boff + n * 2048 + k * 1024); } while (0)
#define G8_MMA(ai, bj, At, Bt) do { __builtin_amdgcn_s_setprio(1); _Pragma("unroll") for (int m = 0; m < 4; ++m) _Pragma("unroll") for (int n = 0; n < 2; ++n) _Pragma("unroll") for (int k = 0; k < 2; ++k) \
        acc[ai][bj][m][n] = __builtin_amdgcn_mfma_f32_16x16x32_bf16(Bt[n][k], At[m][k], acc[ai][bj][m][n], 0, 0, 0); __builtin_amdgcn_s_setprio(0); } while (0)
#define G8_WAIT_V(n) asm volatile("s_waitcnt vmcnt(" #n ")" ::: "memory")
#define G8_WAIT_L(n) asm volatile("s_waitcnt lgkmcnt(" #n ")" ::: "memory")
#define G8_BAR __builtin_amdgcn_s_barrier()
#define G8_SCHED __builtin_amdgcn_sched_barrier(0)
    UnitG cur, nxt; int ui = 0;
    if (!S.next(0, cur)) return;
    f32x4 acc[2][2][4][2];
#pragma unroll
    for (int a = 0; a < 2; ++a)
#pragma unroll
        for (int b = 0; b < 2; ++b)
#pragma unroll
            for (int m = 0; m < 4; ++m)
#pragma unroll
                for (int n = 0; n < 2; ++n) acc[a][b][m][n] = (f32x4){0.f, 0.f, 0.f, 0.f};
    bf16x8 At[4][2], B0[2][2], B1[2][2];
    unsigned ao[2][2];
    const size_t hstepA = (size_t)HALF * S.pitch();
#pragma unroll
    for (int i = 0; i < 2; ++i) { ao[0][i] = S.aoff(0, R0 + 64 * i, C0 * 2); ao[1][i] = Sched::GATHER ? S.aoff(0, R0 + 64 * i + 128, C0 * 2) : 0u; }
    const char* cA = cur.A; const char* cB = cur.B;
    G8_STAGE(G8_SB(0, 0), cB, voffB); G8_STAGE(G8_SB(0, 1), cB + hstep, voffB); G8_STAGE_A(G8_SA(0, 0), cA, 0); G8_STAGE_A(G8_SA(0, 1), cA, 1);
    if (wr == 1) G8_BAR;
    G8_WAIT_V(2); G8_BAR;
    G8_STAGE(G8_SB(1, 0), cB + kstep, voffB); G8_STAGE_A(G8_SA(1, 0), cA + kstep, 0); G8_STAGE(G8_SB(1, 1), cB + hstep + kstep, voffB);
    G8_WAIT_V(6); G8_BAR;
    for (;;) {
        const bool has_next = S.next(ui + 1, nxt);
        const char* nA = has_next ? nxt.A : cA; const char* nB = has_next ? nxt.B : cB;
#pragma unroll 1
        for (int t = 0; t < nt; t += 2) {
            const bool last = (t == nt - 2);
            const char* a1 = cA + (size_t)(t + 1) * kstep;
            const char* a2 = last ? nA : cA + (size_t)(t + 2) * kstep; const char* b2 = last ? nB : cB + (size_t)(t + 2) * kstep;
            const char* a3 = a2 + kstep; const char* b3 = b2 + kstep;
            if constexpr (Sched::GATHER) { if (last && has_next) {
#pragma unroll
                for (int i = 0; i < 2; ++i) ao[0][i] = S.aoff(ui + 1, R0 + 64 * i, C0 * 2); } }
            G8_LDB(B0, 0, 0); G8_LDB(B1, 0, 1); G8_SCHED; G8_LDA(At, 0, 0); G8_STAGE_A(G8_SA(1, 1), a1, 1);
            if constexpr (Sched::GATHER) { if (last && has_next) {
#pragma unroll
                for (int i = 0; i < 2; ++i) ao[1][i] = S.aoff(ui + 1, R0 + 64 * i + 128, C0 * 2); } }
            G8_WAIT_V(8); G8_WAIT_L(0); G8_BAR; G8_MMA(0, 0, At, B0); G8_MMA(0, 1, At, B1); G8_BAR; G8_SCHED;
            G8_LDA(At, 0, 1); G8_STAGE(G8_SB(0, 0), b2, voffB); G8_STAGE(G8_SB(0, 1), b2 + hstep, voffB); G8_STAGE_A(G8_SA(0, 0), a2, 0);
            G8_WAIT_V(8); G8_WAIT_L(0); G8_BAR; G8_MMA(1, 0, At, B0); G8_MMA(1, 1, At, B1); G8_BAR; G8_SCHED;
            G8_LDB(B0, 1, 0); G8_LDB(B1, 1, 1); G8_SCHED; G8_LDA(At, 1, 0); G8_STAGE_A(G8_SA(0, 1), a2, 1);
            G8_WAIT_V(8); G8_WAIT_L(0); G8_BAR; G8_MMA(0, 0, At, B0); G8_MMA(0, 1, At, B1); G8_BAR; G8_SCHED;
            G8_LDA(At, 1, 1); G8_STAGE(G8_SB(1, 0), b3, voffB); G8_STAGE(G8_SB(1, 1), b3 + hstep, voffB); G8_STAGE_A(G8_SA(1, 0), a3, 0);
            G8_WAIT_V(8); G8_WAIT_L(0); G8_BAR; G8_MMA(1, 0, At, B0); G8_MMA(1, 1, At, B1); G8_BAR; G8_SCHED;
        }
        if (wr == 0) G8_BAR;
        E(acc, cur, wr, wc, fr, fq);
        if (!has_next) break;
#pragma unroll
        for (int a = 0; a < 2; ++a)
#pragma unroll
            for (int b = 0; b < 2; ++b)
#pragma unroll
                for (int m = 0; m < 4; ++m)
#pragma unroll
                    for (int n = 0; n < 2; ++n) acc[a][b][m][n] = (f32x4){0.f, 0.f, 0.f, 0.f};
        cur = nxt; cA = nA; cB = nB; ++ui;
        if (wr == 1) G8_BAR;
    }
    G8_WAIT_V(0);
    G8_BAR;
#undef G8_SA
#undef G8_SB
#undef G8_STAGE
#undef G8_STAGE_A
#undef G8_LDA
#undef G8_LDB
#undef G8_MMA
#undef G8_WAIT_V
#undef G8_WAIT_L
#undef G8_BAR
#undef G8_SCHED
}

struct DenseSched {
    const char* A; const char* Bt; char* O; int K, nM, nN, nwg, G, c, ldo, obytes;
    __device__ __forceinline__ void init(const void* A_, const void* Bt_, void* O_, int M, int N, int K_, int ldo_, int obytes_, int G_, int c_) {
        A = (const char*)A_; Bt = (const char*)Bt_; O = (char*)O_; K = K_; nM = M / BM; nN = N / BM; nwg = nM * nN; G = G_; c = c_; ldo = ldo_; obytes = obytes_; }
    __device__ __forceinline__ bool next(int i, UnitG& u) const {
        const long L = (long)i * G + c; if (L >= nwg) return false;
        int wgid = (int)L; { const int q = nwg / NXCD, r = nwg % NXCD, xcd = wgid % NXCD, off = wgid / NXCD; wgid = (xcd < r ? xcd * (q + 1) : r * (q + 1) + (xcd - r) * q) + off; }
        const int nig = WGM * nN, gid = wgid / nig, fm = gid * WGM, gsz = (nM - fm) < WGM ? (nM - fm) : WGM;
        const int pm = fm + ((wgid % nig) % gsz), pn = (wgid % nig) / gsz;
        u.p0 = pm; u.p1 = pn; u.p2 = 0; u.A = A + (size_t)pm * BM * K * 2; u.B = Bt + (size_t)pn * BM * K * 2;
        u.O = O + (size_t)pm * BM * ldo + (size_t)pn * BM * obytes; u.ldo = ldo; return true;
    }
    static constexpr bool GATHER = false;
    __device__ __forceinline__ int pitch() const { return K * 2; }
    __device__ __forceinline__ unsigned aoff(int, int row, int cb) const { return (unsigned)(row * K * 2 + cb); }
};
struct EpiBf16 {
    static constexpr int PMODE = 1;
    __device__ __forceinline__ void operator()(const f32x4 (&acc)[2][2][4][2], const UnitG& u, int wr, int wc, int fr, int fq) const {
        asm volatile("" : "+v"(fr), "+v"(fq));
#pragma unroll
        for (int ai = 0; ai < 2; ++ai)
#pragma unroll
            for (int m = 0; m < 4; ++m) { char* rowp = u.O + (size_t)(ai * HALF + wr * 64 + m * 16 + fr) * u.ldo + (wc * 32 + 8 * fq) * 2;
#pragma unroll
                for (int bj = 0; bj < 2; ++bj) { const f32x4 v0 = acc[ai][bj][m][0], v1 = acc[ai][bj][m][1];
                    u32x4 w; w.x = cvt_pk_bf16(v0[0], v0[1]); w.y = cvt_pk_bf16(v0[2], v0[3]); w.z = cvt_pk_bf16(v1[0], v1[1]); w.w = cvt_pk_bf16(v1[2], v1[3]);
                    *(u32x4*)(rowp + bj * HALF * 2) = w; } }
    }
};
struct EpiF32 {
    static constexpr int PMODE = 0;
    __device__ __forceinline__ void operator()(const f32x4 (&acc)[2][2][4][2], const UnitG& u, int wr, int wc, int fr, int fq) const {
        asm volatile("" : "+v"(fr), "+v"(fq));
#pragma unroll
        for (int ai = 0; ai < 2; ++ai)
#pragma unroll
            for (int m = 0; m < 4; ++m) { char* rowp = u.O + (size_t)(ai * HALF + wr * 64 + m * 16 + fr) * u.ldo + (wc * 32 + 4 * fq) * 4;
#pragma unroll
                for (int bj = 0; bj < 2; ++bj)
#pragma unroll
                    for (int n = 0; n < 2; ++n) *(f32x4*)(rowp + (bj * HALF + n * 16) * 4) = acc[ai][bj][m][n]; }
    }
};
struct EpiH {
    static constexpr int PMODE = 1;
    __device__ __forceinline__ void operator()(const f32x4 (&acc)[2][2][4][2], const UnitG& u, int wr, int wc, int fr, int fq) const {
        asm volatile("" : "+v"(fr), "+v"(fq));
        const int valid = u.p1;
#pragma unroll
        for (int ai = 0; ai < 2; ++ai)
#pragma unroll
            for (int m = 0; m < 4; ++m) { const int r = ai * HALF + wr * 64 + m * 16 + fr;
                if (r < valid) {
                    const f32x4 g0 = acc[ai][0][m][0], g1 = acc[ai][0][m][1], u0 = acc[ai][1][m][0], u1 = acc[ai][1][m][1];
                    float h[8];
#pragma unroll
                    for (int j = 0; j < 4; ++j) { h[j] = siluf_(g0[j]) * u0[j]; h[4 + j] = siluf_(g1[j]) * u1[j]; }
                    *(u32x4*)(u.O + (size_t)r * u.ldo + (wc * 32 + 8 * fq) * 2) = pack8(h); } }
    }
};
struct EpiY {
    static constexpr int PMODE = 2;
    const float* sgate;
    __device__ __forceinline__ void operator()(const f32x4 (&acc)[2][2][4][2], const UnitG& u, int wr, int wc, int fr, int fq) const {
        asm volatile("" : "+v"(fr), "+v"(fq));
        const int valid = u.p1, slot0 = u.p0; const bool shared = u.p2 != 0;
#pragma unroll
        for (int ai = 0; ai < 2; ++ai)
#pragma unroll
            for (int m = 0; m < 4; ++m) { const int r = ai * HALF + wr * 64 + m * 16 + fr;
                if (r < valid) {
                    if (shared) {
                        char* rowp = u.O + (size_t)r * u.ldo + (wc * 64 + 16 * fq) * 2;
#pragma unroll
                        for (int bj = 0; bj < 2; ++bj) { const f32x4 v0 = acc[ai][bj][m][0], v1 = acc[ai][bj][m][1];
                            u32x4 w; w.x = cvt_pk_bf16(v0[0], v0[1]); w.y = cvt_pk_bf16(v0[2], v0[3]); w.z = cvt_pk_bf16(v1[0], v1[1]); w.w = cvt_pk_bf16(v1[2], v1[3]);
                            *(u32x4*)(rowp + bj * 16) = w; }
                    } else {
                        const float gt = sgate[slot0 + r] * 32.0f;
                        u32x4 w; int t_;
#pragma unroll
                        for (int bj = 0; bj < 2; ++bj) { const f32x4 v0 = acc[ai][bj][m][0] * gt, v1 = acc[ai][bj][m][1] * gt;
                            t_ = 0; t_ = __builtin_amdgcn_cvt_pk_fp8_f32(v0[0], v0[1], t_, false); t_ = __builtin_amdgcn_cvt_pk_fp8_f32(v0[2], v0[3], t_, true); w[2 * bj] = (unsigned)t_;
                            t_ = 0; t_ = __builtin_amdgcn_cvt_pk_fp8_f32(v1[0], v1[1], t_, false); t_ = __builtin_amdgcn_cvt_pk_fp8_f32(v1[2], v1[3], t_, true); w[2 * bj + 1] = (unsigned)t_; }
                        *(u32x4*)(u.O + (size_t)r * u.ldo + wc * 64 + 16 * fq) = w;
                    } } }
    }
};
}

template <int OFF> __device__ __forceinline__ unsigned long long karg64() {
    unsigned long long v;
    asm volatile("s_load_dwordx2 %0, %1, %2\n\ts_waitcnt lgkmcnt(0)" : "=&s"(v) : "s"((unsigned long long)__builtin_amdgcn_kernarg_segment_ptr()), "n"(OFF) : "memory");
    return v;
}
template <int OFF> __device__ __forceinline__ int karg32() {
    int v;
    asm volatile("s_load_dword %0, %1, %2\n\ts_waitcnt lgkmcnt(0)" : "=&s"(v) : "s"((unsigned long long)__builtin_amdgcn_kernarg_segment_ptr()), "n"(OFF) : "memory");
    return v;
}
#define KIN(k) ((const float*)karg64<8 * (k)>())
#define KOUT() ((float*)karg64<176>())
#define KWS() ((unsigned char*)karg64<184>())
struct Args { const float* in[22]; float* out; unsigned char* ws; int ph_lo, ph_hi, li, pad; };
struct Frame {
    LAS unsigned char* lds;
    int tid, lane, wave, vcu, G;
};
static_assert(offsetof(Args, out) == 176 && offsetof(Args, ws) == 184 && offsetof(Args, ph_lo) == 192 && offsetof(Args, ph_hi) == 196, "Args layout");

enum { GT_BASE = 0, GT_N = 1, GT_TOT0 = 2, GT_YB0 = 3, GT_YB1 = 4, GT_TS1 = 5, GT_TS20 = 6, GT_TS21 = 7 };

__device__ __forceinline__ void tr_item(const float* W, int ldw, int k0, int c0, bf16* WT, int ldt, int drow0, LAS float* scr, int lane) {
#pragma unroll 8
    for (int i = 0; i < 32; ++i) { const int kk = 2 * i + (lane >> 5); scr[kk * 33 + (lane & 31)] = W[(size_t)(k0 + kk) * ldw + c0 + (lane & 31)]; }
    LDS_WAIT(); asm volatile("" ::: "memory");
    const int c = lane & 7;
#pragma unroll
    for (int j = 0; j < 4; ++j) { const int n = (lane >> 3) + 8 * j; const LAS float* s = scr + (8 * c) * 33 + n;
        u32x4 o; o.x = cvt_pk_bf16(s[0 * 33], s[1 * 33]); o.y = cvt_pk_bf16(s[2 * 33], s[3 * 33]); o.z = cvt_pk_bf16(s[4 * 33], s[5 * 33]); o.w = cvt_pk_bf16(s[6 * 33], s[7 * 33]);
        *(u32x4*)(WT + (size_t)(drow0 + n) * ldt + k0 + 8 * c) = o; }
    LDS_WAIT(); asm volatile("" ::: "memory");
}
__device__ __forceinline__ void tr_item64(const float* W, int ldw, int k0, int c0, bf16* WT, int ldt, int drow0, LAS float* scr, int lane) {
    f32x4 v[16];
#pragma unroll
    for (int i = 0; i < 16; ++i) v[i] = *(const f32x4*)(W + (size_t)(k0 + 4 * i + (lane >> 4)) * ldw + c0 + 4 * (lane & 15));
#pragma unroll
    for (int i = 0; i < 16; ++i) { LAS float* d = scr + (4 * i + (lane >> 4)) * 65 + 4 * (lane & 15); d[0] = v[i].x; d[1] = v[i].y; d[2] = v[i].z; d[3] = v[i].w; }
    LDS_WAIT(); asm volatile("" ::: "memory");
    const int c = lane & 7;
#pragma unroll
    for (int j = 0; j < 8; ++j) { const int n = (lane >> 3) + 8 * j; const LAS float* s = scr + (8 * c) * 65 + n;
        u32x4 o; o.x = cvt_pk_bf16(s[0 * 65], s[1 * 65]); o.y = cvt_pk_bf16(s[2 * 65], s[3 * 65]); o.z = cvt_pk_bf16(s[4 * 65], s[5 * 65]); o.w = cvt_pk_bf16(s[6 * 65], s[7 * 65]);
        *(u32x4*)(WT + (size_t)(drow0 + n) * ldt + k0 + 8 * c) = o; }
    LDS_WAIT(); asm volatile("" ::: "memory");
}
__device__ __forceinline__ void p0_prologue(Frame& F) {
    unsigned char* const ws_ = KWS(); float* const out_ = KOUT(); (void)ws_; (void)out_;
    const float* x = KIN(0); const float* meta = KIN(1); const float* w_in = KIN(2);
    LAS float* wbd = (LAS float*)(F.lds);
    LAS float* scr = (LAS float*)(F.lds + 32768 + F.wave * 8704);
    for (int i = F.tid; i < 8 * 1024; i += NTHREADS) { const int c = i >> 10, k = i & 1023; wbd[i] = w_in[(size_t)k * INC + NPJ + c]; }
    __syncthreads();
    const int gw = F.vcu * NWAVES + F.wave, NGW = F.G * NWAVES;
    bf16* xb = (bf16*)(ws_ + WS_RA); float* bd = (float*)(ws_ + TB_BD);
    for (int t = gw; t < T; t += NGW) {
        const f32x4* xr = (const f32x4*)(x + (size_t)t * D) + F.lane;
        f32x4 v[4];
#pragma unroll
        for (int j = 0; j < 4; ++j) v[j] = xr[64 * j];
        u32x2* o8 = (u32x2*)(xb + (size_t)t * D) + F.lane;
#pragma unroll
        for (int j = 0; j < 4; ++j) { u32x2 w; w.x = cvt_pk_bf16(v[j].x, v[j].y); w.y = cvt_pk_bf16(v[j].z, v[j].w); o8[64 * j] = w; }
        float s[8];
#pragma unroll
        for (int c = 0; c < 8; ++c) { float acc = 0.f;
#pragma unroll
            for (int j = 0; j < 4; ++j) { const f32x4 w = *(const LAS f32x4*)(wbd + c * 1024 + 256 * j + 4 * F.lane); acc += v[j].x * w.x + v[j].y * w.y + v[j].z * w.z + v[j].w * w.w; }
            s[c] = wave_sum(acc); }
        if (F.lane < 8) { float r = s[0];
#pragma unroll
            for (int c = 1; c < 8; ++c) r = (F.lane == c) ? s[c] : r;
            bd[(size_t)t * 8 + F.lane] = r; }
    }
    bf16* WinT = (bf16*)(ws_ + W_WINT); bf16* WoutT = (bf16*)(ws_ + W_WOUTT); bf16* WrT = (bf16*)(ws_ + W_WRT); bf16* Wsgu = (bf16*)(ws_ + W_WSGU); bf16* Wsd = (bf16*)(ws_ + W_WSD);
    constexpr int I_IN = 16 * 112, I_OUT = 16 * 32, I_R = 16 * 8, I_SG = 16 * 8, I_SU = 16 * 8, I_SD = 4 * 32;
    constexpr int NITEMS = I_IN + I_OUT + I_R + I_SG + I_SU + I_SD;
    for (int it = gw; it < NITEMS; it += NGW) {
        int r = it;
        if (r < I_IN) { const int kb = r / 112, nb = r % 112; tr_item(w_in, INC, 64 * kb, 32 * nb, WinT, D, 32 * nb, scr, F.lane); continue; } r -= I_IN;
        if (r < I_OUT) { const int kb = r / 32, nb = r % 32; tr_item(KIN(9), D, 64 * kb, 32 * nb, WoutT, D, 32 * nb, scr, F.lane); continue; } r -= I_OUT;
        if (r < I_R) { const int kb = r / 8, nb = r % 8; tr_item(KIN(12), NE, 64 * kb, 32 * nb, WrT, D, 32 * nb, scr, F.lane); continue; } r -= I_R;
        if (r < I_SG) { const int kb = r / 8, nb = r % 8; tr_item(KIN(17), EFF, 64 * kb, 32 * nb, Wsgu, D, 256 * (nb >> 2) + 32 * (nb & 3), scr, F.lane); continue; } r -= I_SG;
        if (r < I_SU) { const int kb = r / 8, nb = r % 8; tr_item(KIN(18), EFF, 64 * kb, 32 * nb, Wsgu, D, 256 * (nb >> 2) + 128 + 32 * (nb & 3), scr, F.lane); continue; } r -= I_SU;
        { const int kb = r / 32, nb = r % 32; tr_item(KIN(19), D, 64 * kb, 32 * nb, Wsd, EFF, 32 * nb, scr, F.lane); }
    }
    float* projm = (float*)(ws_ + TB_PROJM);
    for (int idx = F.vcu * NTHREADS + F.tid; idx < INC * 4; idx += F.G * NTHREADS) {
        const int col = idx % INC, rg = idx / INC;
        float acc[4] = {0.f, 0.f, 0.f, 0.f};
        for (int k = 0; k < D; ++k) { const float w = w_in[(size_t)k * INC + col];
#pragma unroll
            for (int r = 0; r < 4; ++r) acc[r] += meta[(rg * 4 + r) * D + k] * w; }
#pragma unroll
        for (int r = 0; r < 4; ++r) projm[(rg * 4 + r) * INC + col] = acc[r];
    }
}

__device__ __forceinline__ void p2_ld8(const bf16* proj, const float* projm, bool metarun, int b, int pos, int col, float (&o)[8]) {
    if (pos < 0 && metarun) {
#pragma unroll
        for (int j = 0; j < 8; ++j) o[j] = 0.f;
        return; }
    if (pos < 0 || metarun) { const int p = metarun ? pos : 16 + pos; const f32x4* s = (const f32x4*)(projm + (size_t)p * INC + col); const f32x4 a0 = s[0], a1 = s[1];
        o[0] = a0.x; o[1] = a0.y; o[2] = a0.z; o[3] = a0.w; o[4] = a1.x; o[5] = a1.y; o[6] = a1.z; o[7] = a1.w; return; }
    const u32x4 w = *(const u32x4*)(proj + (size_t)(b * SEQ + pos) * NPJ + col); unpack8(w, o);
}
__device__ __forceinline__ void p2_prep(Frame& F) {
    unsigned char* const ws_ = KWS(); float* const out_ = KOUT(); (void)ws_; (void)out_;
    const bf16* proj = (const bf16*)(ws_ + WS_RB); const float* projm = (const float*)(ws_ + TB_PROJM); const float* bd = (const float*)(ws_ + TB_BD);
    bf16* ycat = (bf16*)(ws_ + WS_RA); bf16* qn = (bf16*)(ws_ + WS_QN); bf16* kn = (bf16*)(ws_ + WS_KN); bf16* vv = (bf16*)(ws_ + WS_VV); bf16* zb = (bf16*)(ws_ + WS_ZB);
    float* betab = (float*)(ws_ + TB_BETA); float* gb = (float*)(ws_ + TB_G);
    bf16* mq = (bf16*)(ws_ + TB_METAQ); bf16* mk = (bf16*)(ws_ + TB_METAK); bf16* mv = (bf16*)(ws_ + TB_METAV); float* mbeta = (float*)(ws_ + TB_METAB); float* mg = (float*)(ws_ + TB_METAG);
    const float* conv_w = KIN(3); const float* conv_nw = KIN(4); const float* gconv_w = KIN(5); const float* a_log = KIN(6); const float* dt_bias = KIN(7);
    const int gw = F.vcu * NWAVES + F.wave, NGW = F.G * NWAVES, lane = F.lane, ch = 8 * lane;
    for (int rid = gw; rid < 2049; rid += NGW) {
        const bool metarun = (rid == 2048);
        const int b = metarun ? 0 : (rid >> 6), s0 = metarun ? 0 : (rid & 63) * 32, len = metarun ? 16 : 32;
        if (metarun) {
            for (int r = 0; r < 48; ++r) { const u32x4 z = (u32x4){0u, 0u, 0u, 0u}; *(u32x4*)(mq + r * 512 + ch) = z; *(u32x4*)(mk + r * 512 + ch) = z; *(u32x4*)(mv + r * 512 + ch) = z; }
            for (int i = lane; i < 48 * 4; i += 64) { mbeta[i] = 0.f; mg[i] = 0.f; }
        }
        if (!metarun) {
            float w0[8], w1[8], w2[8], nw[8];
#pragma unroll
            for (int j = 0; j < 8; ++j) { w0[j] = conv_w[ch + j]; w1[j] = conv_w[CW + ch + j]; w2[j] = conv_w[2 * CW + ch + j]; nw[j] = conv_nw[ch + j]; }
            float c2[8], c1[8], t0[8], t1[8];
            p2_ld8(proj, projm, false, b, s0 - 2, CW + ch, t0); p2_ld8(proj, projm, false, b, s0 - 2, 2 * CW + ch, t1);
#pragma unroll
            for (int j = 0; j < 8; ++j) c2[j] = t0[j] * t1[j];
            p2_ld8(proj, projm, false, b, s0 - 1, CW + ch, t0); p2_ld8(proj, projm, false, b, s0 - 1, 2 * CW + ch, t1);
#pragma unroll
            for (int j = 0; j < 8; ++j) c1[j] = t0[j] * t1[j];
#pragma unroll 1
            for (int s = s0; s < s0 + 32; s += 2) {
                u32x4 la[2], lb_[2], lc[2], lz[2];
#pragma unroll
                for (int u = 0; u < 2; ++u) { const bf16* rowp = proj + (size_t)(b * SEQ + s + u) * NPJ + ch;
                    la[u] = *(const u32x4*)(rowp + CW); lb_[u] = *(const u32x4*)(rowp + 2 * CW); lc[u] = *(const u32x4*)(rowp); lz[u] = *(const u32x4*)(rowp + 3072); }
#pragma unroll
                for (int u = 0; u < 2; ++u) {
                    float gbv[8], y[8], c0[8];
                    unpack8(la[u], t0); unpack8(lb_[u], t1); unpack8(lc[u], gbv);
                    float ss = 0.f;
#pragma unroll
                    for (int j = 0; j < 8; ++j) { c0[j] = t0[j] * t1[j]; y[j] = gbv[j] * (w0[j] * c2[j] + w1[j] * c1[j] + w2[j] * c0[j]); ss += y[j] * y[j]; c2[j] = c1[j]; c1[j] = c0[j]; }
                    ss = wave_sum(ss);
                    const float rms = 1.0f / sqrtf(ss * (1.0f / CW) + EPS);
#pragma unroll
                    for (int j = 0; j < 8; ++j) y[j] = y[j] * rms * nw[j];
                    *(u32x4*)(ycat + (size_t)(b * SEQ + s + u) * D + ch) = pack8(y);
                    *(u32x4*)(zb + (size_t)(b * SEQ + s + u) * GWID + ch) = lz[u];
                }
            }
        }
#pragma unroll 1
        for (int p = 0; p < 3; ++p) {
            const int cb = 1536 + 512 * p + ch;
            float w0[8], w1[8], w2[8], w3[8];
#pragma unroll
            for (int j = 0; j < 8; ++j) { w0[j] = gconv_w[512 * p + ch + j]; w1[j] = gconv_w[1536 + 512 * p + ch + j]; w2[j] = gconv_w[2 * 1536 + 512 * p + ch + j]; w3[j] = gconv_w[3 * 1536 + 512 * p + ch + j]; }
            float r3[8], r2[8], r1[8], r0[8];
            p2_ld8(proj, projm, metarun, b, s0 - 3, cb, r3); p2_ld8(proj, projm, metarun, b, s0 - 2, cb, r2); p2_ld8(proj, projm, metarun, b, s0 - 1, cb, r1);
            bf16* dst = metarun ? (p == 0 ? mq : (p == 1 ? mk : mv)) : (p == 0 ? qn : (p == 1 ? kn : vv));
#pragma unroll 1
            for (int s = s0; s < s0 + len; s += 4) {
                u32x4 lr[4];
                if (!metarun) {
#pragma unroll
                    for (int u = 0; u < 4; ++u) lr[u] = *(const u32x4*)(proj + (size_t)(b * SEQ + s + u) * NPJ + cb);
                }
#pragma unroll
                for (int u = 0; u < 4; ++u) {
                    if (metarun) p2_ld8(proj, projm, true, b, s + u, cb, r0); else unpack8(lr[u], r0);
                    float y[8]; float ss = 0.f;
#pragma unroll
                    for (int j = 0; j < 8; ++j) { const float c = w0[j] * r3[j] + w1[j] * r2[j] + w2[j] * r1[j] + w3[j] * r0[j]; y[j] = siluf_(c); ss += y[j] * y[j]; r3[j] = r2[j]; r2[j] = r1[j]; r1[j] = r0[j]; }
                    if (p < 2) {
                        ss += __shfl_xor(ss, 1); ss += __shfl_xor(ss, 2); ss += __shfl_xor(ss, 4); ss += __shfl_xor(ss, 8);
                        const float sc = (1.0f / sqrtf(ss + 1e-6f)) * (p == 0 ? 0.08838834764831845f : 1.0f);
#pragma unroll
                        for (int j = 0; j < 8; ++j) y[j] *= sc;
                    }
                    const size_t row = metarun ? (size_t)(48 + s + u) : (size_t)(b * SEQ + s + u);
                    *(u32x4*)(dst + row * GWID + ch) = pack8(y);
                }
            }
        }
        for (int i = lane; i < len * 8; i += 64) {
            const int s = s0 + (i >> 3), c = i & 7, h = c & 3;
            const float v = metarun ? projm[(size_t)s * INC + NPJ + c] : bd[(size_t)(b * SEQ + s) * 8 + c];
            const size_t row = metarun ? (size_t)(48 + s) : (size_t)(b * SEQ + s);
            if (c < 4) { const float be = 1.0f / (1.0f + expf(-v)); (metarun ? mbeta : betab)[row * 4 + h] = be; }
            else { const float xx = v + dt_bias[h]; const float sp = fmaxf(xx, 0.f) + log1pf(expf(-fabsf(xx))); (metarun ? mg : gb)[row * 4 + h] = -expf(a_log[h]) * sp; }
        }
    }
}

__device__ __forceinline__ int perm_pos(int d) { return (d & ~31) | (((d >> 2) & 3) << 3) | (((d >> 4) & 1) << 2) | (d & 3); }
constexpr int P3_QT = 0, P3_KT = 17408, P3_LT = 34816, P3_SC = 51200, P3_OUT = 52224;
__device__ __forceinline__ void p3_gdn_local(Frame& F) {
    unsigned char* const ws_ = KWS(); float* const out_ = KOUT(); (void)ws_; (void)out_;
    LAS unsigned char* lds = F.lds;
    const int wave = F.wave;
    LAS float* sc_gc = (LAS float*)(lds + P3_SC);
    LAS float* sc_beta = sc_gc + 64;
    LAS float* sc_g = sc_gc + 128;
    LAS float* LT = (LAS float*)(lds + P3_LT);
    for (int unit = F.vcu; unit < 4100; unit += F.G) {
        int tid = F.tid; asm volatile("" : "+v"(tid));
        int lane = tid & 63;
        const bool metau = unit >= 4096;
        const int h = unit & 3, bc = unit >> 2;
        const size_t row0 = metau ? 0 : (size_t)bc * 64;
        const bf16* qp = metau ? (const bf16*)(ws_ + TB_METAQ) : (const bf16*)(ws_ + WS_QN);
        const bf16* kp = metau ? (const bf16*)(ws_ + TB_METAK) : (const bf16*)(ws_ + WS_KN);
        const bf16* vp = metau ? (const bf16*)(ws_ + TB_METAV) : (const bf16*)(ws_ + WS_VV);
        const float* gp = metau ? (const float*)(ws_ + TB_METAG) : (const float*)(ws_ + TB_G);
        const float* bp = metau ? (const float*)(ws_ + TB_METAB) : (const float*)(ws_ + TB_BETA);
        unsigned char* blk = ws_ + WS_RB + (size_t)unit * GBLK;
#pragma unroll
        for (int i = 0; i < 2; ++i) { const int p = tid + 512 * i, r = p >> 4, c16 = p & 15;
            *(LAS u32x4*)(lds + P3_QT + r * 272 + c16 * 16) = *(const u32x4*)(qp + (row0 + r) * GWID + h * HD + c16 * 8);
            *(LAS u32x4*)(lds + P3_KT + r * 272 + c16 * 16) = *(const u32x4*)(kp + (row0 + r) * GWID + h * HD + c16 * 8); }
        if (tid < 64) sc_g[tid] = gp[(row0 + tid) * 4 + h];
        else if (tid < 128) sc_beta[tid - 64] = bp[(row0 + tid - 64) * 4 + h];
        __syncthreads();
        float gcl = sc_g[lane];
#pragma unroll
        for (int o = 1; o < 64; o <<= 1) { const float y = __shfl_up(gcl, o); if (lane >= o) gcl += y; }
        sc_gc[lane] = gcl;
        LDS_WAIT(); asm volatile("" ::: "memory");
        const float glast = __shfl(gcl, 63);
        {
            const int fr = lane & 15, fq = lane >> 4, mt = wave >> 1;
#pragma unroll
            for (int tn = 0; tn < 2; ++tn) {
                const int ntl = 2 * (wave & 1) + tn;
                f32x4 akk = (f32x4){0.f, 0.f, 0.f, 0.f}, aqk = (f32x4){0.f, 0.f, 0.f, 0.f};
#pragma unroll
                for (int s = 0; s < 4; ++s) {
                    const bf16x8 ki = *(const LAS bf16x8*)(lds + P3_KT + (16 * mt + fr) * 272 + (32 * s + 8 * fq) * 2);
                    const bf16x8 qi = *(const LAS bf16x8*)(lds + P3_QT + (16 * mt + fr) * 272 + (32 * s + 8 * fq) * 2);
                    const bf16x8 kj = *(const LAS bf16x8*)(lds + P3_KT + (16 * ntl + fr) * 272 + (32 * s + 8 * fq) * 2);
                    akk = __builtin_amdgcn_mfma_f32_16x16x32_bf16(ki, kj, akk, 0, 0, 0);
                    aqk = __builtin_amdgcn_mfma_f32_16x16x32_bf16(qi, kj, aqk, 0, 0, 0);
                }
                const int j = 16 * ntl + fr; const float gcj = sc_gc[j];
                f32x4 lv;
#pragma unroll
                for (int jj = 0; jj < 4; ++jj) { const int i = 16 * mt + 4 * fq + jj; const float dec = fast_exp(fminf(sc_gc[i] - gcj, 0.f));
                    lv[jj] = (i > j) ? sc_beta[i] * akk[jj] * dec : 0.f;
                    const float at = (i >= j) ? aqk[jj] * dec : 0.f;
                    *(LAS bf16*)(lds + P3_OUT + GB_ATT + i * 144 + perm_pos(j) * 2) = (bf16)(cvt_pk_bf16(at, 0.f) & 0xffffu); }
                *(LAS f32x4*)(LT + j * 64 + 16 * mt + 4 * fq) = lv;
            }
        }
        __syncthreads();
        asm volatile("" : "+v"(tid));
        if (tid < 256) {
            const bool isu = tid < 128; const int pos = perm_pos(tid - 128);
#pragma unroll 1
            for (int I = 0; I < 4; ++I) {
                float r[16];
                if (isu) {
#pragma unroll
                    for (int ii = 0; ii < 16; ++ii) r[ii] = sc_beta[16 * I + ii] * bf2f(vp[(row0 + 16 * I + ii) * GWID + h * HD + tid]);
                } else {
#pragma unroll
                    for (int ii = 0; ii < 16; ++ii) r[ii] = sc_beta[16 * I + ii] * fast_exp(sc_gc[16 * I + ii]) * bf2f(*(const LAS bf16*)(lds + P3_KT + (16 * I + ii) * 272 + (tid - 128) * 2));
                }
#pragma unroll 1
                for (int J = 0; J < I; ++J) {
                    float xs[16];
                    if (isu) { float t8[8];
                        unpack8(*(const LAS u32x4*)(lds + P3_OUT + GB_UT + tid * 144 + 32 * J), t8);
#pragma unroll
                        for (int q = 0; q < 8; ++q) xs[q] = t8[q];
                        unpack8(*(const LAS u32x4*)(lds + P3_OUT + GB_UT + tid * 144 + 32 * J + 16), t8);
#pragma unroll
                        for (int q = 0; q < 8; ++q) xs[8 + q] = t8[q];
                    } else {
#pragma unroll
                        for (int jj = 0; jj < 16; ++jj) xs[jj] = -bf2f(*(const LAS bf16*)(lds + P3_OUT + GB_WP + (16 * J + jj) * 272 + pos * 2));
                    }
#pragma unroll
                    for (int jj = 0; jj < 16; ++jj)
#pragma unroll
                        for (int q4 = 0; q4 < 4; ++q4) { const f32x4 l = *(const LAS f32x4*)(LT + (16 * J + jj) * 64 + 16 * I + 4 * q4);
                            r[4 * q4 + 0] -= l.x * xs[jj]; r[4 * q4 + 1] -= l.y * xs[jj]; r[4 * q4 + 2] -= l.z * xs[jj]; r[4 * q4 + 3] -= l.w * xs[jj]; }
                }
#pragma unroll
                for (int jj = 0; jj < 15; ++jj) { const float xj = r[jj];
#pragma unroll
                    for (int i4 = ((jj + 1) & ~3); i4 < 16; i4 += 4) { const f32x4 l = *(const LAS f32x4*)(LT + (16 * I + jj) * 64 + 16 * I + i4);
                        r[i4 + 0] -= l.x * xj; r[i4 + 1] -= l.y * xj; r[i4 + 2] -= l.z * xj; r[i4 + 3] -= l.w * xj; } }
                if (isu) {
#pragma unroll
                    for (int c8 = 0; c8 < 2; ++c8) { u32x4 w; w.x = cvt_pk_bf16(r[8 * c8 + 0], r[8 * c8 + 1]); w.y = cvt_pk_bf16(r[8 * c8 + 2], r[8 * c8 + 3]); w.z = cvt_pk_bf16(r[8 * c8 + 4], r[8 * c8 + 5]); w.w = cvt_pk_bf16(r[8 * c8 + 6], r[8 * c8 + 7]);
                        *(LAS u32x4*)(lds + P3_OUT + GB_UT + tid * 144 + 32 * I + c8 * 16) = w; }
                } else {
#pragma unroll
                    for (int ii = 0; ii < 16; ++ii) *(LAS bf16*)(lds + P3_OUT + GB_WP + (16 * I + ii) * 272 + pos * 2) = (bf16)(cvt_pk_bf16(-r[ii], 0.f) & 0xffffu);
                }
                asm volatile("" ::: "memory");
            }
        } else {
            const int tt = tid - 256;
            {
                const int c = tt >> 2, s = tt & 3; const float e = fast_exp(sc_gc[c]);
                float v[32];
#pragma unroll
                for (int g4 = 0; g4 < 4; ++g4) { const u32x4 w = *(const LAS u32x4*)(lds + P3_QT + c * 272 + (32 * s + 8 * g4) * 2); float t8[8]; unpack8(w, t8);
#pragma unroll
                    for (int j = 0; j < 8; ++j) v[8 * g4 + j] = t8[j] * e; }
#pragma unroll
                for (int q = 0; q < 4; ++q) { float o8[8];
#pragma unroll
                    for (int j = 0; j < 8; ++j) o8[j] = v[16 * (j >> 2) + 4 * q + (j & 3)];
                    *(LAS u32x4*)(lds + P3_OUT + GB_QD + c * 272 + (32 * s + 8 * q) * 2) = pack8(o8); }
            }
            {
                const int dk = tt >> 1, s = tt & 1;
                float v[32];
#pragma unroll
                for (int i = 0; i < 32; ++i) { const int c = 32 * s + i; v[i] = bf2f(*(const LAS bf16*)(lds + P3_KT + c * 272 + dk * 2)) * fast_exp(glast - sc_gc[c]); }
#pragma unroll
                for (int q = 0; q < 4; ++q) { float o8[8];
#pragma unroll
                    for (int j = 0; j < 8; ++j) o8[j] = v[16 * (j >> 2) + 4 * q + (j & 3)];
                    *(LAS u32x4*)(lds + P3_OUT + GB_KDT + dk * 144 + (32 * s + 8 * q) * 2) = pack8(o8); }
            }
        }
        __syncthreads();
        if (GDN_PROBE) {
            unsigned flags = 0u;
            { const int i = tid >> 3;
              for (int jj = 0; jj < 8; ++jj) { const int j = (tid & 7) * 8 + jj; float dq = 0.f, dkk = 0.f;
                  for (int d = 0; d < 128; ++d) { const float kj = bf2f(*(const LAS bf16*)(lds + P3_KT + j * 272 + d * 2)); dq += bf2f(*(const LAS bf16*)(lds + P3_QT + i * 272 + d * 2)) * kj; dkk += bf2f(*(const LAS bf16*)(lds + P3_KT + i * 272 + d * 2)) * kj; }
                  const float dec = (i >= j) ? expf(sc_gc[i] - sc_gc[j]) : 0.f;
                  const float ra = (i >= j) ? dq * dec : 0.f, ga = bf2f(*(const LAS bf16*)(lds + P3_OUT + GB_ATT + i * 144 + perm_pos(j) * 2));
                  if (!(fabsf(ga - ra) <= 0.02f * fabsf(ra) + 1e-4f)) flags |= 1u;
                  const float rl = (i > j) ? sc_beta[i] * dkk * dec : 0.f, gl = LT[j * 64 + i];
                  if (!(fabsf(gl - rl) <= 2e-3f * fabsf(rl) + 1e-5f)) flags |= 2u; } }
            { const int c = tid >> 3;
              for (int x = 0; x < 16; ++x) { const int dk = (tid & 7) * 16 + x;
                  const float rq = bf2f(*(const LAS bf16*)(lds + P3_QT + c * 272 + dk * 2)) * expf(sc_gc[c]), gq = bf2f(*(const LAS bf16*)(lds + P3_OUT + GB_QD + c * 272 + perm_pos(dk) * 2));
                  if (!(fabsf(gq - rq) <= 0.02f * fabsf(rq) + 1e-6f)) flags |= 4u;
                  const float rk = bf2f(*(const LAS bf16*)(lds + P3_KT + c * 272 + dk * 2)) * expf(glast - sc_gc[c]), gk = bf2f(*(const LAS bf16*)(lds + P3_OUT + GB_KDT + dk * 144 + perm_pos(c) * 2));
                  if (!(fabsf(gk - rk) <= 0.02f * fabsf(rk) + 1e-6f)) flags |= 8u; } }
            if (tid < 256) {
#define XS(i) (tid < 128 ? bf2f(*(const LAS bf16*)(lds + P3_OUT + GB_UT + tid * 144 + (i) * 2)) : -bf2f(*(const LAS bf16*)(lds + P3_OUT + GB_WP + (i) * 272 + perm_pos(tid - 128) * 2)))
#pragma unroll 1
                for (int i = 0; i < 64; ++i) {
                    const float rhs = tid < 128 ? sc_beta[i] * bf2f(vp[(row0 + i) * GWID + h * HD + tid]) : sc_beta[i] * expf(sc_gc[i]) * bf2f(*(const LAS bf16*)(lds + P3_KT + i * 272 + (tid - 128) * 2));
                    const float xi = XS(i); float acc = xi, mag = fabsf(rhs) + fabsf(xi);
#pragma unroll 1
                    for (int j = 0; j < i; ++j) { const float tl = LT[j * 64 + i] * XS(j); acc += tl; mag += fabsf(tl); }
                    if (!(fabsf(acc - rhs) <= 0.03f * mag + 1e-5f)) flags |= (tid < 128 ? 16u : 32u);
                }
#undef XS
            }
            if (flags) atomicOr((unsigned*)(ws_ + WS_CTL) + CW_DBG, flags);
        }
        asm volatile("" : "+v"(tid));
        for (int p = tid; p < GB_EG / 16; p += NTHREADS) { const u32x4 w = *(const LAS u32x4*)(lds + P3_OUT + p * 16); *(u32x4*)(blk + p * 16) = w;
 }
        if (tid == 0) *(float*)(blk + GB_EG) = fast_exp(glast);
        __syncthreads();
    }
}

constexpr int P4_IN = 0, P4_OT = 81920;
__device__ __forceinline__ void p4_gdn_scan(Frame& F) {
    unsigned char* const ws_ = KWS(); float* const out_ = KOUT(); (void)ws_; (void)out_;
    if (F.vcu >= BATCH * NHEAD) return;
    LAS unsigned char* lds = F.lds;
    const int tid = F.tid, lane = F.lane, wv = F.wave, fr = lane & 15, fq = lane >> 4;
    const int b = F.vcu >> 2, h = F.vcu & 3;
    const float* gnw = KIN(8);
    const bf16* zb = (const bf16*)(ws_ + WS_ZB); bf16* ycat = (bf16*)(ws_ + WS_RA);
    const unsigned char* gbase = ws_ + WS_RB;
    f32x4 S[8]; bf16x8 Sb[4];
#pragma unroll
    for (int i = 0; i < 8; ++i) S[i] = (f32x4){0.f, 0.f, 0.f, 0.f};
#pragma unroll
    for (int i = 0; i < 4; ++i) Sb[i] = (bf16x8){0, 0, 0, 0, 0, 0, 0, 0};
    constexpr int NPIECE = GBLK / 16;
    u32x4 pre[10];
    {
        const unsigned char* blk = gbase + (size_t)(4096 + h) * GBLK;
#pragma unroll
        for (int i = 0; i < 10; ++i) pre[i] = *(const u32x4*)(blk + (size_t)(tid + 512 * i) * 16);
#pragma unroll
        for (int i = 0; i < 10; ++i) *(LAS u32x4*)(lds + P4_IN + (tid + 512 * i) * 16) = pre[i];
    }
    __syncthreads();
    for (int n = 0; n <= 32; ++n) {
        if (n < 32) {
            const unsigned char* blk = gbase + (size_t)(((b * 32 + n) * 4) + h) * GBLK;
#pragma unroll
            for (int i = 0; i < 10; ++i) pre[i] = *(const u32x4*)(blk + (size_t)(tid + 512 * i) * 16);
        }
        const float eg = *(const LAS float*)(lds + P4_IN + GB_EG);
        f32x4 o[4], v[4];
#pragma unroll
        for (int mt = 0; mt < 4; ++mt) { o[mt] = (f32x4){0.f, 0.f, 0.f, 0.f};
            const u32x2 w = *(const LAS u32x2*)(lds + P4_IN + GB_UT + (16 * wv + fr) * 144 + (16 * mt + 4 * fq) * 2);
            v[mt] = (f32x4){bf_lo(w.x), bf_hi(w.x), bf_lo(w.y), bf_hi(w.y)}; }
#pragma unroll
        for (int s = 0; s < 4; ++s)
#pragma unroll
            for (int mt = 0; mt < 4; ++mt) {
                const bf16x8 aw = *(const LAS bf16x8*)(lds + P4_IN + GB_WP + (16 * mt + fr) * 272 + (32 * s + 8 * fq) * 2);
                const bf16x8 aq = *(const LAS bf16x8*)(lds + P4_IN + GB_QD + (16 * mt + fr) * 272 + (32 * s + 8 * fq) * 2);
                v[mt] = __builtin_amdgcn_mfma_f32_16x16x32_bf16(aw, Sb[s], v[mt], 0, 0, 0);
                o[mt] = __builtin_amdgcn_mfma_f32_16x16x32_bf16(aq, Sb[s], o[mt], 0, 0, 0);
            }
        bf16x8 vb[2];
#pragma unroll
        for (int s2 = 0; s2 < 2; ++s2) { u32x4 w; w.x = cvt_pk_bf16(v[2 * s2][0], v[2 * s2][1]); w.y = cvt_pk_bf16(v[2 * s2][2], v[2 * s2][3]); w.z = cvt_pk_bf16(v[2 * s2 + 1][0], v[2 * s2 + 1][1]); w.w = cvt_pk_bf16(v[2 * s2 + 1][2], v[2 * s2 + 1][3]);
            vb[s2] = __builtin_bit_cast(bf16x8, w); }
#pragma unroll
        for (int s2 = 0; s2 < 2; ++s2)
#pragma unroll
            for (int mt = 0; mt < 4; ++mt) {
                const bf16x8 at = *(const LAS bf16x8*)(lds + P4_IN + GB_ATT + (16 * mt + fr) * 144 + (32 * s2 + 8 * fq) * 2);
                o[mt] = __builtin_amdgcn_mfma_f32_16x16x32_bf16(at, vb[s2], o[mt], 0, 0, 0);
            }
#pragma unroll
        for (int dt = 0; dt < 8; ++dt) { S[dt] = S[dt] * eg;
#pragma unroll
            for (int s2 = 0; s2 < 2; ++s2) {
                const bf16x8 ak = *(const LAS bf16x8*)(lds + P4_IN + GB_KDT + (16 * dt + fr) * 144 + (32 * s2 + 8 * fq) * 2);
                S[dt] = __builtin_amdgcn_mfma_f32_16x16x32_bf16(ak, vb[s2], S[dt], 0, 0, 0);
            } }
#pragma unroll
        for (int s = 0; s < 4; ++s) { u32x4 w; w.x = cvt_pk_bf16(S[2 * s][0], S[2 * s][1]); w.y = cvt_pk_bf16(S[2 * s][2], S[2 * s][3]); w.z = cvt_pk_bf16(S[2 * s + 1][0], S[2 * s + 1][1]); w.w = cvt_pk_bf16(S[2 * s + 1][2], S[2 * s + 1][3]);
            Sb[s] = __builtin_bit_cast(bf16x8, w); }
        if (n >= 1) {
#pragma unroll
            for (int mt = 0; mt < 4; ++mt)
#pragma unroll
                for (int jj = 0; jj < 4; ++jj) *(LAS float*)(lds + P4_OT + ((16 * mt + 4 * fq + jj) * 132 + 16 * wv + fr) * 4) = o[mt][jj];
        }
        __syncthreads();
        if (GDN_PROBE && n == 0) { bool bad = false;
#pragma unroll
            for (int dt = 0; dt < 8; ++dt)
#pragma unroll
                for (int j = 0; j < 4; ++j) bad |= !(fabsf(S[dt][j]) < 1e30f);
            if (bad) atomicOr((unsigned*)(ws_ + WS_CTL) + CW_DBG, 64u); }
        if (GDN_PROBE && n >= 1) {
            const int row = tid >> 3, part = tid & 7; const size_t t = (size_t)b * SEQ + 64 * (n - 1) + row; const float* ob = (const float*)KOUT() + t * GWID + h * HD + 16 * part;
            float es = 0.f, rs = 0.f; bool bad = false;
#pragma unroll
            for (int q = 0; q < 16; ++q) { const float oc = *(const LAS float*)(lds + P4_OT + (row * 132 + 16 * part + q) * 4), orf = ob[q]; bad |= !(fabsf(oc) < 1e30f); es += (oc - orf) * (oc - orf); rs += orf * orf; }
            es = wave_sum(es); rs = wave_sum(rs);
            if (bad || es > 0.01f * rs) atomicOr((unsigned*)(ws_ + WS_CTL) + CW_DBG, 128u << (n - 1 < 3 ? n - 1 : 3));
        }
        if (!GDN_PROBE && n >= 1) {
            const int row = tid >> 3, part = tid & 7;
            float ov[16]; float ss = 0.f;
#pragma unroll
            for (int q = 0; q < 4; ++q) { const f32x4 t4 = *(const LAS f32x4*)(lds + P4_OT + (row * 132 + 16 * part + 4 * q) * 4); ov[4 * q] = t4.x; ov[4 * q + 1] = t4.y; ov[4 * q + 2] = t4.z; ov[4 * q + 3] = t4.w; }
#pragma unroll
            for (int j = 0; j < 16; ++j) ss += ov[j] * ov[j];
            ss += __shfl_xor(ss, 1); ss += __shfl_xor(ss, 2); ss += __shfl_xor(ss, 4);
            const float rms = 1.0f / sqrtf(ss * (1.0f / HD) + EPS);
            const size_t t = (size_t)b * SEQ + 64 * (n - 1) + row;
            float z8[8];
#pragma unroll
            for (int hh = 0; hh < 2; ++hh) {
                unpack8(*(const u32x4*)(zb + t * GWID + h * HD + 16 * part + 8 * hh), z8);
                float o8[8];
#pragma unroll
                for (int j = 0; j < 8; ++j) { o8[j] = ov[8 * hh + j] * rms * gnw[16 * part + 8 * hh + j] * siluf_(z8[j]); if (DBG_STAGE == 5 && !(fabsf(o8[j]) < 1e30f)) o8[j] = 0.f; }
                *(u32x4*)(ycat + t * D + CW + h * HD + 16 * part + 8 * hh) = pack8(o8);
            }
        }
        if (n < 32) {
#pragma unroll
            for (int i = 0; i < 10; ++i) *(LAS u32x4*)(lds + P4_IN + (tid + 512 * i) * 16) = pre[i];
        }
        __syncthreads();
    }
}


#ifndef GDN_RECURRENT
#define GDN_RECURRENT 0
#endif

__device__ __forceinline__ void p3_gdn_recurrent(Frame& F) {
    unsigned char* const ws_ = KWS();
    LAS float* lk = (LAS float*)(F.lds); LAS float* lq = lk + 64 * 128; LAS float* lv = lq + 64 * 128; LAS float* lb = lv + 64 * 64; LAS float* lg = lb + 64;
    const int tid = F.tid, dvl = tid >> 3, part = tid & 7;
    const int b = F.vcu >> 3, h = (F.vcu >> 1) & 3, dvh = F.vcu & 1;
    float* obuf = KOUT();
    float S[16];
#pragma unroll
    for (int i = 0; i < 16; ++i) S[i] = 0.f;
    for (int grp = 0; grp <= 32; ++grp) {
        const bool mg_ = (grp == 0); const int ntok = mg_ ? 16 : 64;
        const size_t row0 = mg_ ? 48 : (size_t)b * SEQ + 64 * (grp - 1);
        const bf16* qp = mg_ ? (const bf16*)(ws_ + TB_METAQ) : (const bf16*)(ws_ + WS_QN);
        const bf16* kp = mg_ ? (const bf16*)(ws_ + TB_METAK) : (const bf16*)(ws_ + WS_KN);
        const bf16* vp = mg_ ? (const bf16*)(ws_ + TB_METAV) : (const bf16*)(ws_ + WS_VV);
        const float* gp = mg_ ? (const float*)(ws_ + TB_METAG) : (const float*)(ws_ + TB_G);
        const float* bp = mg_ ? (const float*)(ws_ + TB_METAB) : (const float*)(ws_ + TB_BETA);
        __syncthreads();
        for (int i = tid; i < ntok * 128; i += NTHREADS) { const int r = i >> 7, c = i & 127; lk[i] = bf2f(kp[(row0 + r) * GWID + h * HD + c]); lq[i] = bf2f(qp[(row0 + r) * GWID + h * HD + c]); }
        for (int i = tid; i < ntok * 64; i += NTHREADS) { const int r = i >> 6, c = i & 63; lv[i] = bf2f(vp[(row0 + r) * GWID + h * HD + 64 * dvh + c]); }
        if (tid < ntok) { lb[tid] = bp[(row0 + tid) * 4 + h]; lg[tid] = gp[(row0 + tid) * 4 + h]; }
        __syncthreads();
        for (int s = 0; s < ntok; ++s) {
            const float a = expf(lg[s]), be = lb[s];
            float kk[16], qq[16];
#pragma unroll
            for (int i4 = 0; i4 < 4; ++i4) { const f32x4 t4 = *(const LAS f32x4*)(lk + s * 128 + 16 * part + 4 * i4); kk[4 * i4] = t4.x; kk[4 * i4 + 1] = t4.y; kk[4 * i4 + 2] = t4.z; kk[4 * i4 + 3] = t4.w;
                const f32x4 u4 = *(const LAS f32x4*)(lq + s * 128 + 16 * part + 4 * i4); qq[4 * i4] = u4.x; qq[4 * i4 + 1] = u4.y; qq[4 * i4 + 2] = u4.z; qq[4 * i4 + 3] = u4.w; }
            float r = 0.f;
#pragma unroll
            for (int i = 0; i < 16; ++i) r += S[i] * kk[i];
            r += __shfl_xor(r, 1); r += __shfl_xor(r, 2); r += __shfl_xor(r, 4);
            const float vn = be * (lv[s * 64 + dvl] - a * r);
            float o = 0.f;
#pragma unroll
            for (int i = 0; i < 16; ++i) { S[i] = a * S[i] + kk[i] * vn; o += S[i] * qq[i]; }
            o += __shfl_xor(o, 1); o += __shfl_xor(o, 2); o += __shfl_xor(o, 4);
            if (!mg_ && part == 0) obuf[(row0 + s) * GWID + h * HD + 64 * dvh + dvl] = o;
        }
    }
}
__device__ __forceinline__ void p4_gdn_gate(Frame& F) {
    unsigned char* const ws_ = KWS();
    const float* obuf = (const float*)KOUT(); const bf16* zb = (const bf16*)(ws_ + WS_ZB); bf16* ycat = (bf16*)(ws_ + WS_RA); const float* gnw = KIN(8);
    const int gw = F.vcu * NWAVES + F.wave, NGW = F.G * NWAVES, lane = F.lane;
    for (int it = gw; it < T * NHEAD; it += NGW) {
        const size_t t = it >> 2; const int h = it & 3;
        const f32x2 ov = *((const f32x2*)(obuf + t * GWID + h * HD) + lane);
        const float ss = wave_sum(ov.x * ov.x + ov.y * ov.y);
        const float rms = 1.0f / sqrtf(ss * (1.0f / HD) + EPS);
        const unsigned zw = *((const unsigned*)(zb + t * GWID + h * HD) + lane);
        const float o0 = ov.x * rms * gnw[2 * lane] * siluf_(bf_lo(zw)), o1 = ov.y * rms * gnw[2 * lane + 1] * siluf_(bf_hi(zw));
        *((unsigned*)(ycat + t * D + CW + h * HD) + lane) = cvt_pk_bf16(o0, o1);
    }
}

__device__ __forceinline__ void p6_ln1_and_wexp(Frame& F) {
    unsigned char* const ws_ = KWS(); float* const out_ = KOUT(); (void)ws_; (void)out_;
    const float* x = KIN(0); const float* g1 = KIN(10); const float* b1 = KIN(11);
    const bf16* mix = (const bf16*)(ws_ + WS_MIX);
    const int gw = F.vcu * NWAVES + F.wave, NGW = F.G * NWAVES, lane = F.lane;
    for (int t = gw; t < T; t += NGW) {
        const f32x4* xr = (const f32x4*)(x + (size_t)t * D) + lane; const u32x2* mr = (const u32x2*)(mix + (size_t)t * D) + lane;
        f32x4 v[4]; float s = 0.f;
#pragma unroll
        for (int j = 0; j < 4; ++j) { const f32x4 xv = xr[64 * j]; const u32x2 m = (DBG_STAGE == 3) ? (u32x2){0u, 0u} : mr[64 * j];
            v[j] = (f32x4){ALPHA * xv.x + bf_lo(m.x), ALPHA * xv.y + bf_hi(m.x), ALPHA * xv.z + bf_lo(m.y), ALPHA * xv.w + bf_hi(m.y)}; s += (v[j].x + v[j].y) + (v[j].z + v[j].w); }
        const float mean = wave_sum(s) * (1.f / D); float s2 = 0.f;
#pragma unroll
        for (int j = 0; j < 4; ++j) { v[j] = v[j] - mean; s2 += (v[j].x * v[j].x + v[j].y * v[j].y) + (v[j].z * v[j].z + v[j].w * v[j].w); }
        const float rstd = 1.f / sqrtf(wave_sum(s2) * (1.f / D) + EPS);
        u32x2* o8 = (u32x2*)((char*)out_ + (size_t)t * 4096) + lane;
#pragma unroll
        for (int j = 0; j < 4; ++j) { const f32x4 gg = *((const f32x4*)g1 + lane + 64 * j), bb = *((const f32x4*)b1 + lane + 64 * j);
            u32x2 w; w.x = cvt_pk_bf16(v[j].x * rstd * gg.x + bb.x, v[j].y * rstd * gg.y + bb.y); w.y = cvt_pk_bf16(v[j].z * rstd * gg.z + bb.z, v[j].w * rstd * gg.w + bb.w); o8[64 * j] = w; }
    }
    LAS float* scr = (LAS float*)(F.lds + F.wave * 16640);
    bf16* Wgu = (bf16*)(ws_ + WS_X); bf16* Wd = (bf16*)(ws_ + WS_RA);
    const float* wg = KIN(14); const float* wu = KIN(15); const float* wd = KIN(16);
    for (int it = gw; it < NE * 192; it += NGW) {
        const int e = it / 192, r = it % 192;
        if (r < 64) { const int kb = r >> 2, nb = r & 3; tr_item64(wg + (size_t)e * D * EFF, EFF, 64 * kb, 64 * nb, Wgu + (size_t)e * 512 * D, D, 256 * (nb >> 1) + 64 * (nb & 1), scr, lane); }
        else if (r < 128) { const int q = r - 64, kb = q >> 2, nb = q & 3; tr_item64(wu + (size_t)e * D * EFF, EFF, 64 * kb, 64 * nb, Wgu + (size_t)e * 512 * D, D, 256 * (nb >> 1) + 128 + 64 * (nb & 1), scr, lane); }
        else { const int q = r - 128, kb = q >> 4, nb = q & 15; tr_item64(wd + (size_t)e * EFF * D, D, 64 * kb, 64 * nb, Wd + (size_t)e * D * EFF, EFF, 64 * nb, scr, lane); }
    }
}

__device__ __forceinline__ float dpp_f(float v, const int ctrl) {
    const int x = __builtin_bit_cast(int, v);
    int r;
    if (ctrl == 0) r = __builtin_amdgcn_update_dpp(0, x, 0xB1, 0xF, 0xF, true);
    else if (ctrl == 1) r = __builtin_amdgcn_update_dpp(0, x, 0x4E, 0xF, 0xF, true);
    else if (ctrl == 2) r = __builtin_amdgcn_update_dpp(0, x, 0x141, 0xF, 0xF, true);
    else r = __builtin_amdgcn_update_dpp(0, x, 0x140, 0xF, 0xF, true);
    return __builtin_bit_cast(float, r);
}
__device__ __forceinline__ float readlane_f(float v, int l) { return __builtin_bit_cast(float, __builtin_amdgcn_readlane(__builtin_bit_cast(int, v), l)); }
__device__ __forceinline__ float wave_max_dpp(float v) {
    v = fmaxf(v, dpp_f(v, 0)); v = fmaxf(v, dpp_f(v, 1)); v = fmaxf(v, dpp_f(v, 2)); v = fmaxf(v, dpp_f(v, 3));
    return fmaxf(fmaxf(readlane_f(v, 0), readlane_f(v, 16)), fmaxf(readlane_f(v, 32), readlane_f(v, 48)));
}
__device__ __forceinline__ void p8_route(Frame& F) {
    unsigned char* const ws_ = KWS(); float* const out_ = KOUT(); (void)ws_; (void)out_;
    const float* logits = (const float*)(ws_ + WS_LOGITS); const float* brt = KIN(13);
    int* eidx = (int*)(ws_ + TB_EIDX); float* egate = (float*)(ws_ + TB_EGATE); int* wgcnt = (int*)(ws_ + TB_WGCNT);
    LAS int* hist = (LAS int*)(F.lds);
    const int lane = F.lane;
    if (F.tid < 256) hist[F.tid] = 0;
    __syncthreads();
    const f32x4 bias = *((const f32x4*)brt + lane);
    const int wg = F.vcu;
#pragma unroll 1
    for (int tg = 0; tg < 8; ++tg) {
        f32x4 lgs[4];
#pragma unroll
        for (int u = 0; u < 4; ++u) lgs[u] = *((const f32x4*)(logits + (size_t)(wg * 256 + F.wave * 32 + tg * 4 + u) * NE) + lane);
#pragma unroll
        for (int u = 0; u < 4; ++u) {
        const int t = wg * 256 + F.wave * 32 + tg * 4 + u;
        const f32x4 lg = lgs[u];
        float sc[4], sel[4];
#pragma unroll
        for (int i = 0; i < 4; ++i) { sc[i] = 1.0f / (1.0f + expf(-lg[i])); sel[i] = sc[i] + bias[i]; }
        float m1 = fmaxf(sel[0], sel[1]), m2 = fminf(sel[0], sel[1]);
        { const float n1 = fmaxf(sel[2], sel[3]), n2 = fminf(sel[2], sel[3]); const float hi = fmaxf(m1, n1); m2 = fmaxf(fminf(m1, n1), fmaxf(m2, n2)); m1 = hi; }
#pragma unroll
        for (int st = 0; st < 3; ++st) { const float o1 = dpp_f(m1, st), o2 = dpp_f(m2, st); const float hi = fmaxf(m1, o1); m2 = fmaxf(fminf(m1, o1), fmaxf(m2, o2)); m1 = hi; }
        const float gs = m1 + m2; const int myg = lane >> 3; int rank = 0;
#pragma unroll
        for (int g = 0; g < 8; ++g) { const float og = readlane_f(gs, 8 * g); rank += (og > gs || (og == gs && g < myg)) ? 1 : 0; }
        const bool gsel = rank < 4;
#pragma unroll
        for (int i = 0; i < 4; ++i) sel[i] = gsel ? sel[i] : -__builtin_inff();
        int myidx = 0; float mygate = 0.f; float gsum = 0.f;
#pragma unroll
        for (int k = 0; k < 8; ++k) {
            float bv = sel[0]; int bi = 4 * lane;
#pragma unroll
            for (int i = 1; i < 4; ++i) if (sel[i] > bv) { bv = sel[i]; bi = 4 * lane + i; }
            const float mx = wave_max_dpp(bv);
            const unsigned long long tie = __ballot(bv == mx);
            bi = __builtin_amdgcn_readlane(bi, (int)__builtin_ctzll(tie));
            const int sub = bi & 3; const float cand = sub == 0 ? sc[0] : (sub == 1 ? sc[1] : (sub == 2 ? sc[2] : sc[3]));
            const float gk = readlane_f(cand, bi >> 2);
            if (lane == (bi >> 2)) {
#pragma unroll
                for (int i = 0; i < 4; ++i) if (i == sub) sel[i] = -__builtin_inff(); }
            gsum += gk;
            if (lane == k) { myidx = bi; mygate = gk; }
        }
        if (lane < 8) { eidx[(size_t)t * 8 + lane] = myidx; egate[(size_t)t * 8 + lane] = mygate / gsum * 2.5f; __hip_atomic_fetch_add(&hist[myidx], 1, __ATOMIC_RELAXED, __HIP_MEMORY_SCOPE_WORKGROUP); }
    }
    }
    __syncthreads();
    if (F.tid < 256) wgcnt[wg * 256 + F.tid] = hist[F.tid];
}

__device__ __forceinline__ int excl_scan512(int v, LAS int* tmp, int tid, int& total) {
    const int lane = tid & 63, wid = tid >> 6; int x = v;
#pragma unroll
    for (int o = 1; o < 64; o <<= 1) { const int y = __shfl_up(x, o); if (lane >= o) x += y; }
    __syncthreads();
    if (lane == 63) tmp[wid] = x;
    __syncthreads();
    int base = 0, tot = 0;
#pragma unroll
    for (int w = 0; w < 8; ++w) { const int tv = tmp[w]; tot += tv; if (w < wid) base += tv; }
    total = tot;
    return base + x - v;
}
__device__ __forceinline__ void p9_dispatch(Frame& F) {
    unsigned char* const ws_ = KWS(); float* const out_ = KOUT(); (void)ws_; (void)out_;
    const int* wgcnt = (const int*)(ws_ + TB_WGCNT); const int* eidx = (const int*)(ws_ + TB_EIDX); const float* egate = (const float*)(ws_ + TB_EGATE);
    int* yrow = (int*)(ws_ + TB_YROW); unsigned* stok = (unsigned*)(ws_ + TB_STOK); float* sgate = (float*)(ws_ + TB_SGATE); int* gtab = (int*)(ws_ + TB_GTAB);
    LAS int* L = (LAS int*)(F.lds);
    LAS int* s_base = L, *s_tot0 = L + 260, *s_yb0 = L + 520, *s_yb1 = L + 780, *s_my = L + 1040, *s_cnt = L + 1300, *tmp = L + 1560;
    const int tid = F.tid, wg = F.vcu, e = tid;
    int t0 = 0, t1 = 0, my = 0;
    if (tid < 256) {
#pragma unroll 1
        for (int w0 = 0; w0 < 256; w0 += 32) {
            int cv[32];
#pragma unroll
            for (int q = 0; q < 32; ++q) cv[q] = wgcnt[(w0 + q) * 256 + e];
#pragma unroll
            for (int q = 0; q < 32; ++q) { if (w0 < 128) t0 += cv[q]; else t1 += cv[q]; if (w0 + q < wg) my += cv[q]; }
        }
        s_cnt[e] = 0; s_my[e] = my; s_tot0[e] = t0;
    }
    const int n = t0 + t1;
    int tot;
    const int base = excl_scan512(tid < 256 ? n : 0, tmp, tid, tot);
    const int yb0 = excl_scan512(tid < 256 ? t0 : 0, tmp, tid, tot);
    const int yb1 = excl_scan512(tid < 256 ? t1 : 0, tmp, tid, tot);
    int nt1, nt20, nt21;
    const int ts1 = excl_scan512(tid < 256 ? (n + 255) / 256 : 0, tmp, tid, nt1);
    const int ts20 = excl_scan512(tid < 256 ? (t0 + 255) / 256 : 0, tmp, tid, nt20);
    const int ts21 = excl_scan512(tid < 256 ? (t1 + 255) / 256 : 0, tmp, tid, nt21);
    if (tid < 256) { s_base[e] = base; s_yb0[e] = yb0; s_yb1[e] = yb1; }
    if (wg == 0) {
        if (tid < 256) { gtab[GT_BASE * 260 + e] = base; gtab[GT_N * 260 + e] = n; gtab[GT_TOT0 * 260 + e] = t0; gtab[GT_YB0 * 260 + e] = yb0; gtab[GT_YB1 * 260 + e] = yb1;
            gtab[GT_TS1 * 260 + e] = ts1; gtab[GT_TS20 * 260 + e] = ts20; gtab[GT_TS21 * 260 + e] = ts21; }
        if (tid == 0) { gtab[GT_TS1 * 260 + 256] = nt1; gtab[GT_TS20 * 260 + 256] = nt20; gtab[GT_TS21 * 260 + 256] = nt21; }
    }
    __syncthreads();
    const int half = wg >= 128 ? 1 : 0;
    {
        const int t = wg * 256 + (tid >> 1), k0 = (tid & 1) * 4;
        const int4 e4 = *(const int4*)(eidx + (size_t)t * 8 + k0); const f32x4 g4 = *(const f32x4*)(egate + (size_t)t * 8 + k0);
        const int ev[4] = {e4.x, e4.y, e4.z, e4.w};
#pragma unroll
        for (int kk = 0; kk < 4; ++kk) { const int k = k0 + kk; const int ee = ev[kk]; const float gt = g4[kk];
            const int r = __hip_atomic_fetch_add(&s_cnt[ee], 1, __ATOMIC_RELAXED, __HIP_MEMORY_SCOPE_WORKGROUP);
            const int within = s_my[ee] + r;
            const int slot = s_base[ee] + within;
            stok[slot] = (unsigned)t * 4096u; sgate[slot] = gt;
            yrow[(size_t)t * 8 + k] = slot;
        }
    }
    if (tid < 256) { const int t = wg * 256 + tid; stok[NSR + t] = (unsigned)t * 4096u; sgate[NSR + t] = 1.0f; }
    if (wg == 0 && tid < 256) { stok[NSLOT + tid] = 0u; sgate[NSLOT + tid] = 0.f; }
}

__device__ __forceinline__ int find_expert(const LAS int* ts, int tile) {
    int lo = 0, hi = 256;
#pragma unroll 1
    while (hi - lo > 1) { const int mid = (lo + hi) >> 1; if (ts[mid] <= tile) lo = mid; else hi = mid; }
    return lo;
}
struct Gemm1Sched {
    const LAS int* ts; const LAS int* base; const LAS int* nn; const LAS unsigned* tab; int NT1, G, c;
    const char* h1; const char* Wgu; const char* Wsgu; char* Hbuf;
    __device__ __forceinline__ bool next(int i, g8::UnitG& u) const {
        const int L = i * G + c; const int tile = L >> 1, pn = L & 1;
        if (tile >= NT1 + T / 256) return false;
        int e, r, slot0, valid; const char* B;
        if (tile < NT1) { e = find_expert(ts, tile); r = tile - ts[e]; slot0 = base[e] + 256 * r; valid = nn[e] - 256 * r; valid = valid > 256 ? 256 : valid; B = Wgu + ((size_t)(e * 2 + pn) * 256) * D * 2; }
        else { r = tile - NT1; slot0 = NSR + 256 * r; valid = 256; B = Wsgu + ((size_t)pn * 256) * D * 2; }
        u.A = h1; u.B = B; u.O = Hbuf + (size_t)slot0 * (EFF * 2) + pn * 256; u.ldo = EFF * 2; u.p0 = slot0; u.p1 = valid; u.p2 = pn; return true;
    }
    static constexpr bool GATHER = true;
    __device__ __forceinline__ int pitch() const { return 0; }
    __device__ __forceinline__ unsigned aoff(int ui, int row, int cb) const { return tab[ui * 256 + row] + (unsigned)cb; }
};
struct Gemm2Sched {
    const LAS int* ts; const LAS int* base; const LAS int* nn; int NT1, G, c;
    const char* Hbuf; const char* Wd; const char* Wsd; char* Y; char* out;
    __device__ __forceinline__ bool next(int i, g8::UnitG& u) const {
        const int L = i * G + c; const int tile = L >> 2, pn = L & 3;
        if (tile >= NT1 + T / 256) return false;
        if (tile < NT1) { const int e = find_expert(ts, tile), r = tile - ts[e]; const int slot0 = base[e] + 256 * r; int valid = nn[e] - 256 * r; valid = valid > 256 ? 256 : valid;
            u.A = Hbuf + (size_t)slot0 * (EFF * 2); u.B = Wd + ((size_t)e * D + 256 * pn) * EFF * 2; u.O = Y + (size_t)slot0 * 1024 + pn * 256; u.ldo = 1024; u.p0 = slot0; u.p1 = valid; u.p2 = 0; }
        else { const int r = tile - NT1; const int tok0 = 256 * r; const int slot0 = NSR + tok0;
            u.A = Hbuf + (size_t)slot0 * (EFF * 2); u.B = Wsd + ((size_t)256 * pn) * EFF * 2; u.O = out + (size_t)tok0 * 4096 + 2048 + pn * 512; u.ldo = 4096; u.p0 = slot0; u.p1 = 256; u.p2 = 1; }
        return true;
    }
    static constexpr bool GATHER = false;
    __device__ __forceinline__ int pitch() const { return EFF * 2; }
    __device__ __forceinline__ unsigned aoff(int, int row, int cb) const { return (unsigned)(row * EFF * 2 + cb); }
};

__device__ __forceinline__ void p_combine(Frame& F) {
    unsigned char* const ws_ = KWS(); float* const out_ = KOUT();
    const float* g2 = KIN(20); const float* b2 = KIN(21);
    const int* yrow = (const int*)(ws_ + TB_YROW); const char* Y = (const char*)(ws_ + WS_X);
    const int gw = F.vcu * NWAVES + F.wave, NGW = F.G * NWAVES, lane = F.lane;
#pragma unroll 1
    for (int tt0 = gw; tt0 < T; tt0 += NGW) {
        float acc[1][16]; char* orow[1];
#pragma unroll
        for (int u = 0; u < 1; ++u) {
            const int t = tt0 + u;
            orow[u] = (char*)out_ + (size_t)t * 4096;
            const u32x4 h0 = *(const u32x4*)(orow[u] + 32 * lane), h1 = *(const u32x4*)(orow[u] + 32 * lane + 16);
            const u32x4 s0 = *(const u32x4*)(orow[u] + 2048 + 32 * lane), s1 = *(const u32x4*)(orow[u] + 2048 + 32 * lane + 16);
            const int myrow = yrow[(size_t)t * 8 + (lane & 7)];
            u32x4 y0[8];
#pragma unroll
            for (int k = 0; k < 8; ++k) { const int yr = __shfl(myrow, k); y0[k] = *(const u32x4*)(Y + (size_t)yr * 1024 + 16 * lane); }
            float t8[8];
            float rs[16];
#pragma unroll
            for (int j = 0; j < 16; ++j) rs[j] = 0.f;
#pragma unroll
            for (int k = 0; k < 8; ++k) {
#pragma unroll
                for (int q = 0; q < 4; ++q) { const f32x2 lo = __builtin_amdgcn_cvt_pk_f32_fp8((int)y0[k][q], false), hi = __builtin_amdgcn_cvt_pk_f32_fp8((int)y0[k][q], true);
                    rs[4 * q] += lo.x; rs[4 * q + 1] += lo.y; rs[4 * q + 2] += hi.x; rs[4 * q + 3] += hi.y; } }
            unpack8(h0, t8);
#pragma unroll
            for (int j = 0; j < 8; ++j) acc[u][j] = ALPHA * t8[j] + rs[j] * (1.0f / 32.0f);
            unpack8(h1, t8);
#pragma unroll
            for (int j = 0; j < 8; ++j) acc[u][8 + j] = ALPHA * t8[j] + rs[8 + j] * (1.0f / 32.0f);
            unpack8(s0, t8);
#pragma unroll
            for (int j = 0; j < 8; ++j) acc[u][j] += t8[j];
            unpack8(s1, t8);
#pragma unroll
            for (int j = 0; j < 8; ++j) acc[u][8 + j] += t8[j];
        }
#pragma unroll
        for (int u = 0; u < 1; ++u) {
            float s = 0.f;
#pragma unroll
            for (int j = 0; j < 16; ++j) s += acc[u][j];
            const float mean = wave_sum(s) * (1.f / D); float s2 = 0.f;
#pragma unroll
            for (int j = 0; j < 16; ++j) { acc[u][j] -= mean; s2 += acc[u][j] * acc[u][j]; }
            const float rstd = 1.f / sqrtf(wave_sum(s2) * (1.f / D) + EPS);
            float pert = 0.f;
            if (GDN_PROBE) { const unsigned code = *((const unsigned*)(ws_ + WS_CTL) + CW_DBG); if (code) pert = 0.1f * (float)(1 + __builtin_ctz(code)); }
#pragma unroll
            for (int q = 0; q < 4; ++q) { const f32x4 gg = *((const f32x4*)(g2 + 16 * lane) + q), bb = *((const f32x4*)(b2 + 16 * lane) + q);
                *((f32x4*)(orow[u] + 64 * lane) + q) = (f32x4){acc[u][4 * q] * rstd * gg.x + bb.x + pert, acc[u][4 * q + 1] * rstd * gg.y + bb.y + pert, acc[u][4 * q + 2] * rstd * gg.z + bb.z + pert, acc[u][4 * q + 3] * rstd * gg.w + bb.w + pert}; }
        }
    }
}

__device__ __forceinline__ void load_gtabs(Frame& F, LAS int* dst) {
    unsigned char* const ws_ = KWS();
    const int* gtab = (const int*)(ws_ + TB_GTAB);
    for (int i = F.tid; i < 8 * 260; i += NTHREADS) dst[i] = gtab[i];
    __syncthreads();
}

__global__ void __launch_bounds__(NTHREADS, 2) hymba_fwd(Args args) {
    extern __shared__ __attribute__((aligned(16))) unsigned char lds_raw[];
#define MKFRAME() Frame F; { F.lds = (LAS unsigned char*)lds_raw; int t_ = threadIdx.x; asm volatile("" : "+v"(t_)); F.tid = t_; F.lane = t_ & 63; F.wave = __builtin_amdgcn_readfirstlane(t_ >> 6); \
        F.G = gridDim.x; const int bx = blockIdx.x; F.vcu = (F.G % 8 == 0) ? (bx % 8) * (F.G / 8) + bx / 8 : bx; }
    volatile LAS unsigned* MISC = (volatile LAS unsigned*)((LAS unsigned char*)lds_raw + LDS_MISC);
    if (threadIdx.x < 32) MISC[threadIdx.x] = 0u;
    __syncthreads();
    unsigned* ctl = (unsigned*)(KWS() + WS_CTL);
    XcdBarrier bar; bar.bar = ctl + CW_BAR; bar.x = 0; bar.st = nullptr;
    if (MK_LAUNCHES == 1) bar = xcd_barrier_post(ctl + CW_BAR, MISC + 8);
    const int lo = karg32<192>(), hi = karg32<196>();
#ifndef PH_MASK
#define PH_MASK 0x1fff
#endif
#ifndef DUP_MASK
#define DUP_MASK 0
#endif
#define IN(k) ((((PH_MASK) >> (k)) & 1) && lo <= (k) && (k) < hi)
#define DUPN(k) ((((DUP_MASK) >> (k)) & 1) ? 2 : 1)
#define SEAM(k) do { if (IN(k) && IN((k) + 1)) xcd_barrier(bar); } while (0)

    if (IN(0)) for (int rep = 0; rep < DUPN(0); ++rep) { MKFRAME(); p0_prologue(F); __syncthreads(); } SEAM(0);
    if (IN(1)) for (int rep = 0; rep < DUPN(1); ++rep) {
        MKFRAME(); unsigned char* const ws_ = KWS();
        g8::DenseSched S; S.init(ws_ + WS_RA, ws_ + W_WINT, ws_ + WS_RB, T, NPJ, D, NPJ * 2, 2, F.G, (int)blockIdx.x);
        g8::EpiBf16 E; g8::gemm_core<g8::EpiBf16, g8::DenseSched>(F.lds + LDS_STAGE, D, S, E);
    } SEAM(1);
    if (IN(2)) for (int rep = 0; rep < DUPN(2); ++rep) { MKFRAME(); p2_prep(F); } SEAM(2);
#if GDN_RECURRENT
    if (IN(3)) for (int rep = 0; rep < DUPN(3); ++rep) { { MKFRAME(); p3_gdn_recurrent(F); } __syncthreads(); if (GDN_PROBE) { MKFRAME(); p3_gdn_local(F); } } SEAM(3);
    if (IN(4)) for (int rep = 0; rep < DUPN(4); ++rep) { { MKFRAME(); p4_gdn_gate(F); } __syncthreads(); if (GDN_PROBE) { MKFRAME(); p4_gdn_scan(F); } } SEAM(4);
#else
    if (IN(3)) for (int rep = 0; rep < DUPN(3); ++rep) { MKFRAME(); p3_gdn_local(F); } SEAM(3);
    if (IN(4)) for (int rep = 0; rep < DUPN(4); ++rep) { MKFRAME(); p4_gdn_scan(F); __syncthreads(); } SEAM(4);
#endif
    if (IN(5)) for (int rep = 0; rep < DUPN(5); ++rep) {
        MKFRAME(); unsigned char* const ws_ = KWS();
        g8::DenseSched S; S.init(ws_ + WS_RA, ws_ + W_WOUTT, ws_ + WS_MIX, T, D, D, D * 2, 2, F.G, (int)blockIdx.x);
        g8::EpiBf16 E; g8::gemm_core<g8::EpiBf16, g8::DenseSched>(F.lds + LDS_STAGE, D, S, E);
    } SEAM(5);
    if (IN(6)) for (int rep = 0; rep < DUPN(6); ++rep) { MKFRAME(); p6_ln1_and_wexp(F); __syncthreads(); } SEAM(6);
    if (IN(7)) for (int rep = 0; rep < DUPN(7); ++rep) {
        MKFRAME(); unsigned char* const ws_ = KWS(); float* const out_ = KOUT();
        struct RSched : g8::DenseSched {
            __device__ __forceinline__ bool next(int i, g8::UnitG& u) const { if (!g8::DenseSched::next(i, u)) return false; u.A = A + (size_t)u.p0 * 256 * 4096; return true; }
            __device__ __forceinline__ int pitch() const { return 4096; }
            __device__ __forceinline__ unsigned aoff(int, int row, int cb) const { return (unsigned)(row * 4096 + cb); }
        } S; S.init(out_, ws_ + W_WRT, ws_ + WS_LOGITS, T, NE, D, NE * 4, 4, F.G, (int)blockIdx.x);
        g8::EpiF32 E; g8::gemm_core<g8::EpiF32, RSched>(F.lds + LDS_STAGE, D, S, E);
    } SEAM(7);
    if (IN(8)) for (int rep = 0; rep < DUPN(8); ++rep) { MKFRAME(); p8_route(F); __syncthreads(); } SEAM(8);
    if (IN(9)) { MKFRAME(); p9_dispatch(F); } SEAM(9);
    if (IN(10)) for (int rep = 0; rep < DUPN(10); ++rep) {
        MKFRAME(); unsigned char* const ws_ = KWS(); float* const out_ = KOUT();
        LAS int* tb = (LAS int*)(F.lds + LDS_TS); load_gtabs(F, tb);
        Gemm1Sched S; S.ts = tb + GT_TS1 * 260; S.base = tb + GT_BASE * 260; S.nn = tb + GT_N * 260; S.tab = (const LAS unsigned*)(F.lds + LDS_AUX); S.NT1 = tb[GT_TS1 * 260 + 256]; S.G = F.G; S.c = F.vcu;
        S.h1 = (const char*)out_; S.Wgu = (const char*)(ws_ + WS_X); S.Wsgu = (const char*)(ws_ + W_WSGU); S.Hbuf = (char*)(ws_ + WS_HBUF);
        {
            const unsigned* stok = (const unsigned*)(ws_ + TB_STOK); LAS unsigned* tab = (LAS unsigned*)(F.lds + LDS_AUX);
            for (int ui = 0; ui < 20; ++ui) { g8::UnitG u; if (!S.next(ui, u)) break;
                if (F.tid < 256) tab[ui * 256 + F.tid] = stok[u.p0 + (F.tid < u.p1 ? F.tid : 0)]; }
            __syncthreads();
        }
        g8::EpiH E; g8::gemm_core<g8::EpiH, Gemm1Sched>(F.lds + LDS_STAGE, D, S, E);
    } SEAM(10);
    if (IN(11)) for (int rep = 0; rep < DUPN(11); ++rep) {
        MKFRAME(); unsigned char* const ws_ = KWS(); float* const out_ = KOUT();
        LAS int* tb = (LAS int*)(F.lds + LDS_TS); load_gtabs(F, tb);
        Gemm2Sched S; S.ts = tb + GT_TS1 * 260; S.base = tb + GT_BASE * 260; S.nn = tb + GT_N * 260; S.NT1 = tb[GT_TS1 * 260 + 256]; S.G = F.G; S.c = F.vcu;
        S.Hbuf = (const char*)(ws_ + WS_HBUF); S.Wd = (const char*)(ws_ + WS_RA); S.Wsd = (const char*)(ws_ + W_WSD); S.Y = (char*)(ws_ + WS_X); S.out = (char*)out_;
        g8::EpiY E; E.sgate = (const float*)(ws_ + TB_SGATE);
        g8::gemm_core<g8::EpiY, Gemm2Sched>(F.lds + LDS_STAGE, EFF, S, E);
    } SEAM(11);
    if (IN(12)) { MKFRAME(); p_combine(F); }
#undef IN
#undef SEAM
}

extern "C" void kernel_launch(void* const* d_in, const int* in_sizes, int n_in, void* d_out, int out_size, void* d_ws, size_t ws_size, hipStream_t stream) {
    static int grid = 0;
    if (grid == 0) {
        if (n_in != 22 || out_size != T * D || ws_size < WS_END) { fprintf(stderr, "kernel_launch: unexpected shapes (n_in %d out %d ws %zu need %zu)\n", n_in, out_size, ws_size, (size_t)WS_END); grid = -1; return; }
        int dev = 0, cus = 0, per_cu = 0;
        if (hipGetDevice(&dev) != hipSuccess || hipDeviceGetAttribute(&cus, hipDeviceAttributeMultiprocessorCount, dev) != hipSuccess) { grid = -1; return; }
        if (hipFuncSetAttribute((const void*)hymba_fwd, hipFuncAttributeMaxDynamicSharedMemorySize, LDS_BYTES) != hipSuccess) { fprintf(stderr, "kernel_launch: hipFuncSetAttribute failed\n"); grid = -1; return; }
        if (hipOccupancyMaxActiveBlocksPerMultiprocessor(&per_cu, (const void*)hymba_fwd, NTHREADS, LDS_BYTES) != hipSuccess || per_cu < 1) fprintf(stderr, "kernel_launch: occupancy query says %d\n", per_cu);
        (void)hipGetLastError();
        grid = cus;
        if (grid != 256) fprintf(stderr, "kernel_launch: %d CUs (built for 256)\n", grid);
    }
    if (grid < 0) return;
    (void)hipMemsetAsync((char*)d_ws + WS_CTL, 0, CTL_BYTES, stream);
    Args a{};
    for (int i = 0; i < 22; ++i) a.in[i] = (const float*)d_in[i];
    a.out = (float*)d_out; a.ws = (unsigned char*)d_ws; a.li = 0; a.pad = 0;
#if MK_LAUNCHES == 1
    a.ph_lo = 0; a.ph_hi = NPHASE;
    hipLaunchKernelGGL(hymba_fwd, dim3(grid), dim3(NTHREADS), LDS_BYTES, stream, a);
#else
    for (int p = 0; p < NPHASE; ++p) { if ((DBG_STAGE == 1 || DBG_STAGE == 5) && p >= 7 && p != 12 && p != 14) continue; if (DBG_STAGE == 3 && p != 6 && p != 12 && p != 14) continue; if (DBG_STAGE == 4 && p != 0 && p != 1 && p != 2 && p != 5 && p != 6 && p != 12 && p != 14) continue; a.ph_lo = p; a.ph_hi = p + 1; a.li = p; hipLaunchKernelGGL(hymba_fwd, dim3(grid), dim3(NTHREADS), LDS_BYTES, stream, a); }
#endif
}
```
